# Optimizing an MI355X kernel written in HIP

```python
import math
import jax, jax.numpy as jnp
from jax import lax
import numpy as np

D_MODEL = 1024
BATCH = 2
SEQ = 8192
DEPTH = 1

PLE_DIM = 256
HEAD_DIM = 64
DIFF_HEADS = 4
DIFF_QK = 2 * HEAD_DIM
DIFF_V = 2 * HEAD_DIM
DIFF_WIDTH = DIFF_HEADS * DIFF_V
DIL_HEADS = 8
DIL_WIDTH = DIL_HEADS * HEAD_DIM
DIL_PATTERNS = ((128, 1), (512, 4), (2048, 16))
MIX_WIDTH = DIFF_WIDTH + DIL_WIDTH
Q_BLOCK = 128
NORM_EPS = 1e-6
MASK_VALUE = -1e30

IN_SPLIT_SIZES = (
    DIFF_HEADS * DIFF_QK,
    DIFF_HEADS * DIFF_QK,
    DIFF_WIDTH,
    DIL_WIDTH,
    DIL_WIDTH,
    DIL_WIDTH,
    MIX_WIDTH,
)
IN_WIDTH = sum(IN_SPLIT_SIZES)
IN_SPLIT_IDX = tuple(int(v) for v in np.cumsum(IN_SPLIT_SIZES)[:-1])

kernel_name = "hymba_diff_dilated_alibi_ple_encoder"


def rms_norm(t, g):
    tf = t.astype(jnp.float32)
    y = tf * lax.rsqrt(jnp.mean(tf * tf, axis=-1, keepdims=True) + NORM_EPS)
    return (y * g.astype(jnp.float32)).astype(t.dtype)


def alibi_slopes(n_heads):
    return jnp.exp2(-8.0 * jnp.arange(1, n_heads + 1, dtype=jnp.float32) / n_heads)


def diff_attention(q, k, v, lam, slopes):
    B, S, H, _, Dh = q.shape
    scale = Dh ** -0.5
    nqb = S // Q_BLOCK
    pos = jnp.arange(S)
    qb = q.reshape(B, nqb, Q_BLOCK, H, 2, Dh).transpose(1, 0, 2, 3, 4, 5)
    qpos = pos.reshape(nqb, Q_BLOCK)

    def block(args):
        qblk, qp = args
        s = jnp.einsum('bqhce,bkhce->bchqk', qblk, k).astype(jnp.float32) * scale
        dist = jnp.abs(qp[:, None] - pos[None, :]).astype(jnp.float32)
        s = s - slopes[:, None, None] * dist
        a = jax.nn.softmax(s, axis=-1)
        w = a[:, 0] - lam * a[:, 1]
        return jnp.einsum('bhqk,bkhe->bqhe', w.astype(v.dtype), v)

    out = lax.map(block, (qb, qpos))
    return out.transpose(1, 0, 2, 3, 4).reshape(B, S, H, 2 * Dh)


def dilated_branch(q, k, v, slopes, window, dilation):
    B, S, H, Dh = q.shape
    r = window // (2 * dilation)
    blk = r
    unit = dilation * blk
    Lp = -(-S // unit) * unit
    n = Lp // dilation
    nb = n // blk
    scale = Dh ** -0.5

    def split(t):
        t = jnp.pad(t, ((0, 0), (0, Lp - S), (0, 0), (0, 0)))
        return t.reshape(B, nb, blk, dilation, H, Dh)

    def window3(t):
        tp = jnp.pad(t, ((0, 0), (1, 1), (0, 0), (0, 0), (0, 0), (0, 0)))
        return jnp.concatenate([tp[:, :-2], tp[:, 1:-1], tp[:, 2:]], axis=2)

    qs = split(q)
    kw = window3(split(k))
    vw = window3(split(v))

    qi = jnp.arange(nb)[:, None] * blk + jnp.arange(blk)[None, :]
    kj = (jnp.arange(nb)[:, None] - 1) * blk + jnp.arange(3 * blk)[None, :]
    rel = qi[:, :, None] - kj[:, None, :]
    kpos = kj[:, :, None] * dilation + jnp.arange(dilation)[None, None, :]
    key_ok = ((kj >= 0)[:, :, None] & (kpos < S)).transpose(0, 2, 1)
    mask = (jnp.abs(rel) <= r)[:, None, None] & key_ok[:, :, None, None, :]
    dist = (dilation * jnp.abs(rel)).astype(jnp.float32)[:, None, None]
    bias = -slopes[:, None, None] * dist

    s = jnp.einsum('bnqche,bnkche->bnchqk', qs, kw).astype(jnp.float32) * scale + bias
    s = jnp.where(mask, s, MASK_VALUE)
    m = jnp.max(s, axis=-1, keepdims=True)
    e = jnp.exp(s - m)
    l = jnp.sum(e, axis=-1, keepdims=True)
    o = jnp.einsum('bnchqk,bnkche->bnqche', e.astype(v.dtype), vw)
    inv_l = (1.0 / l[..., 0]).transpose(0, 1, 4, 2, 3)[..., None]
    o = (o.astype(jnp.float32) * inv_l).reshape(B, Lp, H, Dh)[:, :S]
    lse = (m[..., 0] + jnp.log(l[..., 0])).transpose(0, 1, 4, 2, 3).reshape(B, Lp, H)[:, :S]
    return o, lse


def dilated_attention(q, k, v, slopes):
    outs, lses = [], []
    for window, dilation in DIL_PATTERNS:
        o, lse = dilated_branch(q, k, v, slopes, window, dilation)
        outs.append(o)
        lses.append(lse)
    w = jax.nn.softmax(jnp.stack(lses, axis=0), axis=0)
    out = jnp.sum(w[..., None] * jnp.stack(outs, axis=0), axis=0)
    return out.astype(q.dtype)


def setup_inputs(seed: int = 0) -> dict:
    key = jax.random.key(seed)
    ks = jax.random.split(key, 20)
    f32 = jnp.float32

    def gain(k, n):
        return 1.0 + 0.02 * jax.random.normal(k, (DEPTH, n), f32)

    return {
        "x": jax.random.normal(ks[0], (BATCH, SEQ, D_MODEL), f32),
        "p": jax.random.normal(ks[1], (DEPTH, BATCH, SEQ, PLE_DIM), f32),
        "mix_norm_g": gain(ks[2], D_MODEL),
        "w_in": jax.random.normal(ks[3], (DEPTH, D_MODEL, IN_WIDTH), f32) * D_MODEL ** -0.5,
        "diff_q_norm_g": gain(ks[4], HEAD_DIM),
        "diff_k_norm_g": gain(ks[5], HEAD_DIM),
        "lambda_q1": 0.1 * jax.random.normal(ks[6], (DEPTH, HEAD_DIM), f32),
        "lambda_k1": 0.1 * jax.random.normal(ks[7], (DEPTH, HEAD_DIM), f32),
        "lambda_q2": 0.1 * jax.random.normal(ks[8], (DEPTH, HEAD_DIM), f32),
        "lambda_k2": 0.1 * jax.random.normal(ks[9], (DEPTH, HEAD_DIM), f32),
        "diff_sub_norm_g": gain(ks[10], DIFF_V),
        "dil_q_norm_g": gain(ks[11], HEAD_DIM),
        "dil_k_norm_g": gain(ks[12], HEAD_DIM),
        "w_out": jax.random.normal(ks[13], (DEPTH, MIX_WIDTH, D_MODEL), f32) * MIX_WIDTH ** -0.5,
        "ple_norm_g": gain(ks[14], D_MODEL),
        "w_ple_gate": jax.random.normal(ks[15], (DEPTH, D_MODEL, D_MODEL), f32) * D_MODEL ** -0.5,
        "w_ple_proj": jax.random.normal(ks[16], (DEPTH, PLE_DIM, D_MODEL), f32) * PLE_DIM ** -0.5,
    }


def reference(x, p, mix_norm_g, w_in, diff_q_norm_g, diff_k_norm_g,
              lambda_q1, lambda_k1, lambda_q2, lambda_k2, diff_sub_norm_g,
              dil_q_norm_g, dil_k_norm_g, w_out, ple_norm_g, w_ple_gate, w_ple_proj):
    B, S, _ = x.shape
    diff_slopes = alibi_slopes(DIFF_HEADS)
    dil_slopes = alibi_slopes(DIL_HEADS)
    for i in range(DEPTH):
        lam_init = 0.8 - 0.6 * math.exp(-0.3 * i)
        h = rms_norm(x, mix_norm_g[i])
        u = h @ w_in[i]
        dq, dk, dv, bq, bk, bv, z = jnp.split(u, IN_SPLIT_IDX, axis=-1)

        dq = rms_norm(dq.reshape(B, S, DIFF_HEADS, 2, HEAD_DIM), diff_q_norm_g[i])
        dk = rms_norm(dk.reshape(B, S, DIFF_HEADS, 2, HEAD_DIM), diff_k_norm_g[i])
        dv = dv.reshape(B, S, DIFF_HEADS, DIFF_V)
        lam = (jnp.exp(jnp.sum(lambda_q1[i].astype(jnp.float32) * lambda_k1[i].astype(jnp.float32)))
               - jnp.exp(jnp.sum(lambda_q2[i].astype(jnp.float32) * lambda_k2[i].astype(jnp.float32)))
               + lam_init)
        a = diff_attention(dq, dk, dv, lam, diff_slopes)
        a = rms_norm(a, diff_sub_norm_g[i]) * (1.0 - lam_init)
        a = a.reshape(B, S, DIFF_WIDTH)

        bq = rms_norm(bq.reshape(B, S, DIL_HEADS, HEAD_DIM), dil_q_norm_g[i])
        bk = rms_norm(bk.reshape(B, S, DIL_HEADS, HEAD_DIM), dil_k_norm_g[i])
        bv = bv.reshape(B, S, DIL_HEADS, HEAD_DIM)
        b = dilated_attention(bq, bk, bv, dil_slopes).reshape(B, S, DIL_WIDTH)

        y = jnp.concatenate([a, b], axis=-1) * jax.nn.silu(z)
        x = x + y @ w_out[i]

        gate = jax.nn.sigmoid(rms_norm(x, ple_norm_g[i]) @ w_ple_gate[i])
        x = x + gate * (p[i] @ w_ple_proj[i])
    return x
```

```cpp
#include <hip/hip_runtime.h>
#include <hip/hip_cooperative_groups.h>
#include <cstdio>
#include <cstdint>
namespace cg = cooperative_groups;
constexpr size_t MiB = 1u << 20;
constexpr size_t WS_CTL = 0, CTL_ZERO_BYTES = 32768, WS_GAINS = 65536, WS_SSQ = 1 * MiB;
constexpr size_t WS_WIN = 2 * MiB, WS_WOUT = 10 * MiB, WS_WPG = 12 * MiB, WS_WPP = 14 * MiB;
constexpr size_t WS_XN = 16 * MiB;
constexpr size_t WS_PB = 48 * MiB;
constexpr size_t WS_QD = 56 * MiB, WS_KD = 72 * MiB, WS_VD = 88 * MiB, WS_QB = 104 * MiB, WS_KB = 120 * MiB, WS_VB = 136 * MiB;
constexpr size_t WS_ZS = 184 * MiB;
constexpr size_t WS_PP = 216 * MiB, WS_END = 248 * MiB;
namespace pg8 {
#define PG8_LAS __attribute__((address_space(3)))
typedef unsigned short bf16_t;
typedef short bf16x8 __attribute__((ext_vector_type(8)));
typedef float f32x4 __attribute__((ext_vector_type(4)));
typedef unsigned u32x4 __attribute__((ext_vector_type(4)));
constexpr int BM = 256, BK = 64, HALF = 128, HTB = HALF * BK * 2  , STAGE_BYTES = 8 * HTB, NXCD = 8, WGM = 8;

__host__ __device__ __forceinline__ int lds_byte(int r, int c) { const int st = (r >> 4) * 2 + (c >> 5), rr = r & 15, cc = c & 31, ob = rr * 64 + cc * 2; return st * 1024 + (ob ^ (((ob >> 9) & 1) << 5)); }
__host__ __device__ __forceinline__ void stage_rc(int b, int& R, int& C) { const int st = b / 1024, sb = b % 1024, swz = sb ^ (((sb >> 9) & 1) << 5); R = (st >> 1) * 16 + swz / 64; C = (st & 1) * 32 + (swz % 64) / 2; }
__host__ __device__ __forceinline__ int perm32(int rho) { const int n = rho >> 4, i = rho & 15; return 8 * (i >> 2) + 4 * n + (i & 3); }

struct Unit { int pm, pn; };
struct Gemm { const bf16_t* A; const bf16_t* Bt; int M, N, K; };

struct StaticOrder {
    int nM, nN, nwg, G, c;
    __host__ __device__ void init(int M, int N, int G_, int c_) { nM = M / BM; nN = N / BM; nwg = nM * nN; G = G_; c = c_; }
    __host__ __device__ bool next(int i, Unit& u) const {
        const long L = (long)i * G + c; if (L >= nwg) return false;
        int wgid = (int)L; { const int q = nwg / NXCD, r = nwg % NXCD, xcd = wgid % NXCD, off = wgid / NXCD; wgid = (xcd < r ? xcd * (q + 1) : r * (q + 1) + (xcd - r) * q) + off; }
        const int nig = WGM * nN, gid = wgid / nig, fm = gid * WGM, gsz = (nM - fm) < WGM ? (nM - fm) : WGM;
        u.pm = fm + ((wgid % nig) % gsz); u.pn = (wgid % nig) / gsz; return true;
    }
    __device__ __forceinline__ void a_ready(const Unit&) const {}
    __device__ __forceinline__ void done(const Unit&) const {}
};
typedef unsigned u32x2 __attribute__((ext_vector_type(2)));
typedef float f32x2 __attribute__((ext_vector_type(2)));
typedef __bf16 bf16x2_t __attribute__((ext_vector_type(2)));
constexpr float LOG2E = 1.4426950408889634f;
constexpr float QSCALE = 0.125f * LOG2E;
constexpr float NORM_EPS = 1e-6f;
constexpr int SEQ = 8192;
__device__ __forceinline__ unsigned pkbf(float lo, float hi) { f32x2 v = {lo, hi}; bf16x2_t b = __builtin_convertvector(v, bf16x2_t); return __builtin_bit_cast(unsigned, b); }
__device__ __forceinline__ bf16_t f2bf(float v) { return (bf16_t)(pkbf(v, 0.f) & 0xffffu); }
__device__ __forceinline__ float bflo(unsigned w) { return __uint_as_float(w << 16); }
__device__ __forceinline__ float bfhi(unsigned w) { return __uint_as_float(w & 0xffff0000u); }
__device__ __forceinline__ float dot4(f32x4 v) { return (v[0] * v[0] + v[1] * v[1]) + (v[2] * v[2] + v[3] * v[3]); }
__device__ __forceinline__ float silu_f(float z) { return z * __builtin_amdgcn_rcpf(1.0f + __expf(-z)); }
__device__ __forceinline__ float sigm_f(float z) { return __builtin_amdgcn_rcpf(1.0f + __expf(-z)); }

typedef unsigned u32x4 __attribute__((ext_vector_type(4)));
__device__ __forceinline__ u32x4 pk8(f32x4 a, f32x4 b) { u32x4 w; w.x = pkbf(a[0], a[1]); w.y = pkbf(a[2], a[3]); w.z = pkbf(b[0], b[1]); w.w = pkbf(b[2], b[3]); return w; }
__device__ __forceinline__ f32x4 silu4(f32x4 v) { return (f32x4){silu_f(v[0]), silu_f(v[1]), silu_f(v[2]), silu_f(v[3])}; }
struct EpiIn {
    static constexpr bool PERM = false, AFTER_DRAIN = false;
    unsigned char* ws; const float* gains;
    __device__ __forceinline__ void operator()(const f32x4 (&acc)[2][2][4][2], const Unit& u, int wr, int wc, int fr, int fq) const {
        const int grp = u.pn * 4 + wc, kind = grp >> 3;
        const int rowb = u.pm * BM + wr * 64 + fr;
        if (kind == 0 || kind == 1 || kind == 3 || kind == 4) {
            const int gsel = kind < 2 ? kind : kind - 1;
            const float* g = gains + 64 * gsel + 8 * fq;
            bf16_t* dst = (bf16_t*)(ws + (kind == 0 ? WS_QD : kind == 1 ? WS_KD : kind == 3 ? WS_QB : WS_KB));
            const int gi = grp & 7;
            f32x4 gv[2][2];
#pragma unroll
            for (int bj = 0; bj < 2; ++bj)
#pragma unroll
                for (int n = 0; n < 2; ++n) gv[bj][n] = *(const f32x4*)(g + 32 * bj + 4 * n);
#pragma unroll
            for (int ai = 0; ai < 2; ++ai)
#pragma unroll
                for (int m = 0; m < 4; ++m) {
                    float ss = (dot4(acc[ai][0][m][0]) + dot4(acc[ai][0][m][1])) + (dot4(acc[ai][1][m][0]) + dot4(acc[ai][1][m][1]));
                    ss += __shfl_xor(ss, 16); ss += __shfl_xor(ss, 32);
                    const float rs = rsqrtf(ss * (1.0f / 64.0f) + NORM_EPS);
                    const int row = rowb + ai * HALF + m * 16, b = row >> 13, s = row & (SEQ - 1);
                    bf16_t* rp = dst + ((size_t)(b * 8 + gi) * SEQ + s) * 64 + 8 * fq;
#pragma unroll
                    for (int bj = 0; bj < 2; ++bj) *(u32x4*)(rp + 32 * bj) = pk8(acc[ai][bj][m][0] * rs * gv[bj][0], acc[ai][bj][m][1] * rs * gv[bj][1]);
                }
        } else {
            const bool isz = kind >= 6;
            int ld, coff; size_t boff, bstride;
            if (kind == 2) { const int gi = grp - 16; ld = 128; coff = 64 * (gi & 1); boff = WS_VD + (size_t)(gi >> 1) * SEQ * 128 * 2; bstride = (size_t)4 * SEQ * 128; }
            else if (kind == 5) { ld = 64; coff = 0; boff = WS_VB + (size_t)(grp - 40) * SEQ * 64 * 2; bstride = (size_t)8 * SEQ * 64; }
            else { ld = 1024; coff = 64 * (grp - 48); boff = WS_ZS; bstride = (size_t)SEQ * 1024; }
            bf16_t* base = (bf16_t*)(ws + boff) + coff + 8 * fq;
#pragma unroll
            for (int ai = 0; ai < 2; ++ai)
#pragma unroll
                for (int m = 0; m < 4; ++m) {
                    const int row = rowb + ai * HALF + m * 16, b = row >> 13, s = row & (SEQ - 1);
                    bf16_t* rp = base + (size_t)b * bstride + (size_t)s * ld;
#pragma unroll
                    for (int bj = 0; bj < 2; ++bj) { f32x4 v0 = acc[ai][bj][m][0], v1 = acc[ai][bj][m][1]; if (isz) { v0 = silu4(v0); v1 = silu4(v1); } *(u32x4*)(rp + 32 * bj) = pk8(v0, v1); }
                }
        }
    }
};
struct EpiPlain {
    static constexpr bool PERM = false, AFTER_DRAIN = false;
    bf16_t* O; int ldc;
    __device__ __forceinline__ void operator()(const f32x4 (&acc)[2][2][4][2], const Unit& u, int wr, int wc, int fr, int fq) const {
        const int rowb = u.pm * BM + wr * 64 + fr, cb = u.pn * BM + 64 * wc + 8 * fq;
#pragma unroll
        for (int ai = 0; ai < 2; ++ai)
#pragma unroll
            for (int m = 0; m < 4; ++m) { bf16_t* rp = O + (size_t)(rowb + ai * HALF + m * 16) * ldc + cb;
#pragma unroll
                for (int bj = 0; bj < 2; ++bj) *(u32x4*)(rp + 32 * bj) = pk8(acc[ai][bj][m][0], acc[ai][bj][m][1]); }
    }
};
struct EpiRes {
    static constexpr bool PERM = false, AFTER_DRAIN = false;
    const float* x; bf16_t* X1B; float* SSQ;
    __device__ __forceinline__ void operator()(const f32x4 (&acc)[2][2][4][2], const Unit& u, int wr, int wc, int fr, int fq) const {
        const int rowb = u.pm * BM + wr * 64 + fr, cb = u.pn * BM + 64 * wc + 8 * fq;
#pragma unroll
        for (int ai = 0; ai < 2; ++ai)
#pragma unroll
            for (int m = 0; m < 4; ++m) { const int row = rowb + ai * HALF + m * 16; const size_t off = (size_t)row * 1024 + cb; float ss = 0.f;
#pragma unroll
                for (int bj = 0; bj < 2; ++bj) { const f32x4 o0 = *(const f32x4*)(x + off + 32 * bj) + acc[ai][bj][m][0], o1 = *(const f32x4*)(x + off + 32 * bj + 4) + acc[ai][bj][m][1];
                    *(u32x4*)(X1B + off + 32 * bj) = pk8(o0, o1); ss += dot4(o0) + dot4(o1); }
                ss += __shfl_xor(ss, 16); ss += __shfl_xor(ss, 32);
                if (fq == 0) SSQ[(size_t)row * 16 + u.pn * 4 + wc] = ss; }
    }
};
struct EpiGate {
    static constexpr bool PERM = false, AFTER_DRAIN = false;
    float* out; const bf16_t* X1B; const bf16_t* PP; const float* SSQ;
    __device__ __forceinline__ void operator()(const f32x4 (&acc)[2][2][4][2], const Unit& u, int wr, int wc, int fr, int fq) const {
        const int rowb = u.pm * BM + wr * 64 + fr, cb = u.pn * BM + 64 * wc + 8 * fq;
#pragma unroll
        for (int ai = 0; ai < 2; ++ai)
#pragma unroll
            for (int m = 0; m < 4; ++m) { const int row = rowb + ai * HALF + m * 16; const size_t off = (size_t)row * 1024 + cb;
                const f32x4* sp = (const f32x4*)(SSQ + (size_t)row * 16); const f32x4 s0 = sp[0], s1 = sp[1], s2 = sp[2], s3 = sp[3];
                const float tot = ((s0[0] + s0[1]) + (s0[2] + s0[3])) + ((s1[0] + s1[1]) + (s1[2] + s1[3])) + ((s2[0] + s2[1]) + (s2[2] + s2[3])) + ((s3[0] + s3[1]) + (s3[2] + s3[3]));
                const float rs = rsqrtf(tot * (1.0f / 1024.0f) + NORM_EPS);
#pragma unroll
                for (int bj = 0; bj < 2; ++bj) { const f32x4 a0 = acc[ai][bj][m][0] * rs, a1 = acc[ai][bj][m][1] * rs; const u32x4 pw = *(const u32x4*)(PP + off + 32 * bj);
                    const u32x4 xw = *(const u32x4*)(X1B + off + 32 * bj); f32x4 o0 = (f32x4){bflo(xw.x), bfhi(xw.x), bflo(xw.y), bfhi(xw.y)}, o1 = (f32x4){bflo(xw.z), bfhi(xw.z), bflo(xw.w), bfhi(xw.w)};
                    o0[0] += sigm_f(a0[0]) * bflo(pw.x); o0[1] += sigm_f(a0[1]) * bfhi(pw.x); o0[2] += sigm_f(a0[2]) * bflo(pw.y); o0[3] += sigm_f(a0[3]) * bfhi(pw.y);
                    o1[0] += sigm_f(a1[0]) * bflo(pw.z); o1[1] += sigm_f(a1[1]) * bfhi(pw.z); o1[2] += sigm_f(a1[2]) * bflo(pw.w); o1[3] += sigm_f(a1[3]) * bfhi(pw.w);
                    __builtin_nontemporal_store(o0, (f32x4*)(out + off + 32 * bj)); __builtin_nontemporal_store(o1, (f32x4*)(out + off + 32 * bj + 4)); } }
    }
};

template <class Epi, class Sched, bool ALIGN_EPI = false, bool SP2 = false>
__device__ __forceinline__ void gemm_phase(PG8_LAS unsigned char* lds, const Gemm g, const Sched& S, const Epi& E) {
    int tid_ = threadIdx.x; asm volatile("" : "+v"(tid_));
    const int tid = tid_, wid = __builtin_amdgcn_readfirstlane(tid >> 6), lane = tid & 63, wr = wid >> 2, wc = wid & 3, fr = lane & 15, fq = lane >> 4;
    const int K = g.K, nt = K / BK;
    unsigned voffA[2], voffB[2];
#pragma unroll
    for (int i = 0; i < 2; ++i) { int R, C; stage_rc(tid * 16 + i * 8192, R, C); const int Rb = Epi::PERM ? ((R & ~31) + perm32(R & 31)) : R;
        voffA[i] = (unsigned)(R * K + C) * 2u; voffB[i] = (unsigned)(Rb * K + C) * 2u; }
    const size_t kstep = (size_t)(BK * 2);
    const size_t hstep = (size_t)HALF * K * 2;
    const size_t tstep = 2 * hstep;
    const unsigned ldsw = (unsigned)wid * 1024u;
    const int aoff = lds_byte(wr * 64 + fr, fq * 8), boff = lds_byte(wc * 32 + fr, fq * 8);
#define PG8_SA(b, h) (((b) * 2 + (h)) * HTB)
#define PG8_SB(b, h) ((4 + (b) * 2 + (h)) * HTB)
#define PG8_STAGE(bufoff, gbase, voff) do { _Pragma("unroll") for (int _i = 0; _i < 2; ++_i) \
        __builtin_amdgcn_global_load_lds((const unsigned*)((const char*)(gbase) + (voff)[_i]), (PG8_LAS unsigned*)(lds + (bufoff) + ldsw + _i * 8192), 16, 0, 0); } while (0)
#define PG8_LDA(dst, b, h) do { _Pragma("unroll") for (int m = 0; m < 4; ++m) _Pragma("unroll") for (int k = 0; k < 2; ++k) dst[m][k] = *(const PG8_LAS bf16x8*)(lds + PG8_SA(b, h) + aoff + m * 2048 + k * 1024); } while (0)
#define PG8_LDB(dst, b, h) do { _Pragma("unroll") for (int n = 0; n < 2; ++n) _Pragma("unroll") for (int k = 0; k < 2; ++k) dst[n][k] = *(const PG8_LAS bf16x8*)(lds + PG8_SB(b, h) + boff + n * 2048 + k * 1024); } while (0)
#define PG8_MMA(ai, bj, At, Bt) do { __builtin_amdgcn_s_setprio(1); _Pragma("unroll") for (int m = 0; m < 4; ++m) _Pragma("unroll") for (int n = 0; n < 2; ++n) _Pragma("unroll") for (int k = 0; k < 2; ++k) \
        acc[ai][bj][m][n] = __builtin_amdgcn_mfma_f32_16x16x32_bf16(Bt[n][k], At[m][k], acc[ai][bj][m][n], 0, 0, 0); __builtin_amdgcn_s_setprio(0); } while (0)
#define PG8_WAIT_V(n) asm volatile("s_waitcnt vmcnt(" #n ")" ::: "memory")
#define PG8_WAIT_L(n) asm volatile("s_waitcnt lgkmcnt(" #n ")" ::: "memory")
#define PG8_BAR __builtin_amdgcn_s_barrier()
#define PG8_SCHED __builtin_amdgcn_sched_barrier(0)
    Unit cur, nxt; int ui = 0;
    if (!S.next(0, cur)) return;
    f32x4 acc[2][2][4][2];
#pragma unroll
    for (int a = 0; a < 2; ++a)
#pragma unroll
        for (int b = 0; b < 2; ++b)
#pragma unroll
            for (int m = 0; m < 4; ++m)
#pragma unroll
                for (int n = 0; n < 2; ++n) acc[a][b][m][n] = (f32x4){0.f, 0.f, 0.f, 0.f};
    bf16x8 At[4][2], B0[2][2], B1[2][2];
    const char* cA = (const char*)g.A + (size_t)cur.pm * tstep; const char* cB = (const char*)g.Bt + (size_t)cur.pn * tstep;
    S.a_ready(cur);
    if constexpr (SP2) {
        PG8_STAGE(PG8_SB(0, 0), cB, voffB); PG8_STAGE(PG8_SB(0, 1), cB + hstep, voffB); PG8_STAGE(PG8_SA(0, 0), cA, voffA); PG8_STAGE(PG8_SA(0, 1), cA + hstep, voffA);
        if (wr == 1) PG8_BAR;
        PG8_WAIT_V(2); PG8_BAR;
        PG8_STAGE(PG8_SB(1, 0), cB + kstep, voffB); PG8_STAGE(PG8_SA(1, 0), cA + kstep, voffA); PG8_STAGE(PG8_SB(1, 1), cB + hstep + kstep, voffB);
        PG8_WAIT_V(6); PG8_BAR;
    } else {
        PG8_STAGE(PG8_SB(0, 0), cB, voffB); PG8_STAGE(PG8_SA(0, 0), cA, voffA); PG8_STAGE(PG8_SB(0, 1), cB + hstep, voffB); PG8_STAGE(PG8_SA(0, 1), cA + hstep, voffA);
        if (wr == 1) PG8_BAR;
        PG8_WAIT_V(4); PG8_BAR;
        PG8_STAGE(PG8_SB(1, 0), cB + kstep, voffB); PG8_STAGE(PG8_SA(1, 0), cA + kstep, voffA); PG8_STAGE(PG8_SB(1, 1), cB + hstep + kstep, voffB);
        PG8_WAIT_V(6); PG8_BAR;
    }
    for (;;) {
        const bool has_next = S.next(ui + 1, nxt);
        const char* nA = has_next ? (const char*)g.A + (size_t)nxt.pm * tstep : cA; const char* nB = has_next ? (const char*)g.Bt + (size_t)nxt.pn * tstep : cB;
        for (int t = 0; t < nt; t += 2) {
            const bool last = (t == nt - 2);
            const char* a1 = cA + (size_t)(t + 1) * kstep;
            const char* a2 = last ? nA : cA + (size_t)(t + 2) * kstep; const char* b2 = last ? nB : cB + (size_t)(t + 2) * kstep;
            const char* a3 = a2 + kstep; const char* b3 = b2 + kstep;
            if (last && has_next) S.a_ready(nxt);
            if constexpr (SP2) {
            PG8_LDB(B0, 0, 0); PG8_LDB(B1, 0, 1); PG8_SCHED; PG8_LDA(At, 0, 0); PG8_STAGE(PG8_SA(1, 1), a1 + hstep, voffA);
            PG8_WAIT_V(8); PG8_WAIT_L(0); PG8_BAR; PG8_MMA(0, 0, At, B0); PG8_MMA(0, 1, At, B1); PG8_BAR; PG8_SCHED;
            PG8_LDA(At, 0, 1); PG8_STAGE(PG8_SB(0, 0), b2, voffB); PG8_STAGE(PG8_SB(0, 1), b2 + hstep, voffB); PG8_STAGE(PG8_SA(0, 0), a2, voffA);
            PG8_WAIT_V(8); PG8_WAIT_L(0); PG8_BAR; PG8_MMA(1, 0, At, B0); PG8_MMA(1, 1, At, B1); PG8_BAR; PG8_SCHED;
            PG8_LDB(B0, 1, 0); PG8_LDB(B1, 1, 1); PG8_SCHED; PG8_LDA(At, 1, 0); PG8_STAGE(PG8_SA(0, 1), a2 + hstep, voffA);
            PG8_WAIT_V(8); PG8_WAIT_L(0); PG8_BAR; PG8_MMA(0, 0, At, B0); PG8_MMA(0, 1, At, B1); PG8_BAR; PG8_SCHED;
            PG8_LDA(At, 1, 1); PG8_STAGE(PG8_SB(1, 0), b3, voffB); PG8_STAGE(PG8_SB(1, 1), b3 + hstep, voffB); PG8_STAGE(PG8_SA(1, 0), a3, voffA);
            PG8_WAIT_V(8); PG8_WAIT_L(0); PG8_BAR; PG8_MMA(1, 0, At, B0); PG8_MMA(1, 1, At, B1); PG8_BAR; PG8_SCHED;
            } else {
            PG8_LDB(B0, 0, 0); PG8_SCHED; PG8_LDA(At, 0, 0); PG8_STAGE(PG8_SA(1, 1), a1 + hstep, voffA);
            PG8_WAIT_L(8); PG8_BAR; PG8_WAIT_L(0); PG8_MMA(0, 0, At, B0); PG8_BAR; PG8_SCHED;
            PG8_LDB(B1, 0, 1); PG8_STAGE(PG8_SB(0, 0), b2, voffB);
            PG8_BAR; PG8_WAIT_L(0); PG8_MMA(0, 1, At, B1); PG8_BAR;
            PG8_LDA(At, 0, 1); PG8_STAGE(PG8_SA(0, 0), a2, voffA);
            PG8_BAR; PG8_WAIT_L(0); PG8_MMA(1, 0, At, B0); PG8_BAR; PG8_SCHED;
            PG8_STAGE(PG8_SB(0, 1), b2 + hstep, voffB);
            PG8_WAIT_V(6); PG8_BAR; PG8_MMA(1, 1, At, B1); PG8_BAR;
            PG8_LDB(B0, 1, 0); PG8_SCHED; PG8_LDA(At, 1, 0); PG8_STAGE(PG8_SA(0, 1), a2 + hstep, voffA);
            PG8_WAIT_L(8); PG8_BAR; PG8_WAIT_L(0); PG8_MMA(0, 0, At, B0); PG8_BAR; PG8_SCHED;
            PG8_LDB(B1, 1, 1); PG8_STAGE(PG8_SB(1, 0), b3, voffB);
            PG8_BAR; PG8_WAIT_L(0); PG8_MMA(0, 1, At, B1); PG8_BAR;
            PG8_LDA(At, 1, 1); PG8_STAGE(PG8_SA(1, 0), a3, voffA);
            PG8_BAR; PG8_WAIT_L(0); PG8_MMA(1, 0, At, B0); PG8_BAR; PG8_SCHED;
            PG8_STAGE(PG8_SB(1, 1), b3 + hstep, voffB);
            PG8_WAIT_V(6); PG8_BAR; PG8_MMA(1, 1, At, B1); PG8_BAR;
            }
        }
        if constexpr (ALIGN_EPI) { if (wr == 0) PG8_BAR; }
        if constexpr (!Epi::AFTER_DRAIN) { int t2 = tid; asm volatile("" : "+v"(t2)); const int l2 = t2 & 63, w2 = __builtin_amdgcn_readfirstlane(t2 >> 6); E(acc, cur, w2 >> 2, w2 & 3, l2 & 15, l2 >> 4); S.done(cur); }
        if (!has_next) break;
#pragma unroll
        for (int a = 0; a < 2; ++a)
#pragma unroll
            for (int b = 0; b < 2; ++b)
#pragma unroll
                for (int m = 0; m < 4; ++m)
#pragma unroll
                    for (int n = 0; n < 2; ++n) acc[a][b][m][n] = (f32x4){0.f, 0.f, 0.f, 0.f};
        cur = nxt; cA = nA; cB = nB; ++ui;
        if constexpr (ALIGN_EPI) { if (wr == 1) PG8_BAR; }
    }
    PG8_WAIT_V(0);
    if constexpr (!ALIGN_EPI) { if (wr == 0) PG8_BAR; }
    PG8_BAR;
    if constexpr (Epi::AFTER_DRAIN) { E.fused(acc, cur, wr, wc, fr, fq, lds, wid, lane); S.done(cur); }
#undef PG8_SA
#undef PG8_SB
#undef PG8_STAGE
#undef PG8_LDA
#undef PG8_LDB
#undef PG8_MMA
#undef PG8_WAIT_V
#undef PG8_WAIT_L
#undef PG8_BAR
#undef PG8_SCHED
}
}

namespace att {
#define LAS3 __attribute__((address_space(3)))
typedef unsigned short bf16_t;
typedef short bf16x8 __attribute__((ext_vector_type(8)));
typedef float f32x16 __attribute__((ext_vector_type(16)));
typedef float f32x4 __attribute__((ext_vector_type(4)));
typedef unsigned u32x4 __attribute__((ext_vector_type(4)));
typedef unsigned u32x2 __attribute__((ext_vector_type(2)));
using pg8::pkbf; using pg8::bflo; using pg8::bfhi; using pg8::LOG2E; using pg8::NORM_EPS;
constexpr int S = 8192;
constexpr int STAGE_B = 32768;
constexpr int XCH_OFF = 65536;
constexpr float NEG_BIG = -30000.0f;
struct AttnP { const bf16_t *QD, *KD, *VD, *QB, *KB, *VB, *ZS; bf16_t* Y; const float* gsub; float lam; int Dh[4]; };

__device__ __forceinline__ int swz(int row, int c) { return row * 128 + ((c ^ ((row >> 1) & 7)) << 4); }
typedef short v4i16_t __attribute__((ext_vector_type(4)));
__device__ __forceinline__ v4i16_t vtr(const LAS3 unsigned char* p) { return __builtin_amdgcn_ds_read_tr16_b64_v4i16((LAS3 v4i16_t*)p); }
__device__ __forceinline__ bf16x8 cat8(v4i16_t lo, v4i16_t hi4) { return (bf16x8){lo[0], lo[1], lo[2], lo[3], hi4[0], hi4[1], hi4[2], hi4[3]}; }
__device__ __forceinline__ int offb(int row, int ch) { return 256 * row + 16 * (ch ^ (((row & 3) << 2) | ((row >> 2) & 3))); }
__device__ __forceinline__ int offv(int row, int ch) { return 128 * row + 16 * (ch ^ (((row >> 1) & 1) << 2)); }
__device__ __forceinline__ void glds16(const void* sbase, unsigned voff, unsigned lds_dst) { unsigned keep;
    asm volatile("s_mov_b32 %0, m0\n\ts_mov_b32 m0, %3\n\ts_nop 0\n\tglobal_load_lds_dwordx4 %1, %2\n\ts_mov_b32 m0, %0" : "=&s"(keep) : "v"(voff), "s"(sbase), "s"(lds_dst) : "memory"); }
__device__ __forceinline__ int perm23(int r) { return (r & 0x13) | ((r & 4) << 1) | ((r & 8) >> 1); }

__device__ __forceinline__ void diff_item(int idx, LAS3 unsigned char* lds, const AttnP& P) {
    int tid_ = threadIdx.x; asm volatile("" : "+v"(tid_));
    const int tid = tid_, lane = tid & 63, r32 = lane & 31, hi = lane >> 5; const int wid = __builtin_amdgcn_readfirstlane(tid >> 6);
    const int strm = wid >> 2, wq = wid & 3;
    const int h = 3 - (idx >> 7), b = (idx >> 6) & 1, qb = idx & 63;
    const int q0 = qb * 128, qpos = q0 + wq * 32 + r32;
    const float slope2 = __builtin_amdgcn_exp2f(-2.0f * (float)(h + 1)) * LOG2E;
    const int D = h == 0 ? P.Dh[0] : h == 1 ? P.Dh[1] : h == 2 ? P.Dh[2] : P.Dh[3];
    int tlo = q0 - 63 - D; tlo = tlo <= 0 ? 0 : ((tlo + 63) >> 6);
    int thi = (q0 + 127 + D) >> 6; if (thi > S / 64 - 1) thi = S / 64 - 1;
    const int tc0 = 2 * qb, nl = tc0 - tlo, nr = thi - (tc0 + 1), nt = 2 + nl + nr;
#define TILE_OF(i) ((i) < 2 ? tc0 + (i) : ((tlo + (i) - 2) < tc0 ? (tlo + (i) - 2) : (tlo + (i))))
    const int kr_ = 8 * wid + (lane >> 3);
    const bf16_t* kb0 = P.KD + ((size_t)(b * 8 + 2 * h) * S) * 64; const bf16_t* kb1 = kb0 + (size_t)S * 64;
    const unsigned kof = (unsigned)(kr_ * 128 + (((lane & 7) ^ ((kr_ >> 1) & 7)) << 4));
    const int vr0_ = 4 * wid + (lane >> 4), vr1_ = 32 + vr0_;
    const bf16_t* vb = P.VD + ((size_t)(b * 4 + h) * S) * 128;
    const unsigned vof0 = (unsigned)(vr0_ * 256 + (((lane & 15) ^ (((vr0_ & 3) << 2) | ((vr0_ >> 2) & 3))) << 4));
    const unsigned vof1 = (unsigned)(vr1_ * 256 + (((lane & 15) ^ (((vr1_ & 3) << 2) | ((vr1_ >> 2) & 3))) << 4));
    const int dK = wid * 1024, dV0 = 16384 + wid * 1024, dV1 = 16384 + 8192 + wid * 1024;
#define DMA16(b_, o_, l_) glds16((b_), (o_), (unsigned)__builtin_amdgcn_readfirstlane((int)(unsigned)(uintptr_t)(l_)))
#define DMA_K(st_, t_) { const unsigned o_ = kof + (unsigned)(t_) * 8192u; DMA16(kb0, o_, (st_) + dK); DMA16(kb1, o_, (st_) + 8192 + dK); }
#define DMA_V(st_, t_) { const unsigned tb_ = (unsigned)(t_) * 16384u; DMA16(vb, vof0 + tb_, (st_) + dV0); DMA16(vb, vof1 + tb_, (st_) + dV1); }
#define DRAIN_BAR() asm volatile("s_waitcnt vmcnt(0) lgkmcnt(0)\n\ts_barrier" ::: "memory")
    bf16x8 qf[4];
    { const bf16_t* qg = P.QD + ((size_t)(b * 8 + 2 * h + strm) * S + qpos) * 64 + 8 * hi;
      asm volatile("global_load_dwordx4 %0, %4, off\n\tglobal_load_dwordx4 %1, %4, off offset:32\n\tglobal_load_dwordx4 %2, %4, off offset:64\n\tglobal_load_dwordx4 %3, %4, off offset:96"
                   : "=&v"(qf[0]), "=&v"(qf[1]), "=&v"(qf[2]), "=&v"(qf[3]) : "v"(qg) : "memory"); }
    const int krow = perm23(r32), kx = (krow >> 1) & 7;
    const int kbase = strm * 8192 + krow * 128;
    int va[2][4];
    { const int blk = (lane >> 4) & 1, q = (lane & 15) >> 2, pp = lane & 3;
#pragma unroll
      for (int t = 0; t < 2; ++t)
#pragma unroll
          for (int dt = 0; dt < 4; ++dt) va[t][dt] = 16384 + 256 * (8 * hi + 4 * t + q) + 16 * (((dt ^ q) << 2) | ((2 * blk + (pp >> 1)) ^ ((2 * hi + t) & 3))) + 8 * (pp & 1); }
    f32x16 o[4];
#pragma unroll
    for (int i = 0; i < 4; ++i) o[i] = f32x16{};
    float l = 0.f;
#define MFMA32(a_, b_, c_) __builtin_amdgcn_mfma_f32_32x32x16_bf16(a_, b_, c_, 0, 0, 0)
#define KFRAG(st_, mt_, ks_) (*(const LAS3 bf16x8*)((st_) + kbase + (mt_) * 4096 + (((2 * (ks_) + hi) ^ kx) << 4)))
#define VFRAG(st_, dt_, kk_) cat8(vtr((st_) + va[0][dt_] + 4096 * (kk_)), vtr((st_) + va[1][dt_] + 4096 * (kk_)))
#define PB_EL(SC, mt_, r_) { const float v_ = __builtin_amdgcn_exp2f(SC[mt_][r_]); SC[mt_][r_] = v_; ls += v_; }
#define PA_EL(SN, mt_, r_) { const float d_ = qrel - (float)(32 * (mt_) + ((r_) & 7) + 16 * ((r_) >> 3)); SN[mt_][r_] = __builtin_fmaf(-slope2, __builtin_fabsf(d_), SN[mt_][r_]); }
#define PACK8(SC, mt_, s8_) __builtin_bit_cast(bf16x8, (u32x4){pkbf(SC[mt_][s8_], SC[mt_][s8_ + 1]), pkbf(SC[mt_][s8_ + 2], SC[mt_][s8_ + 3]), pkbf(SC[mt_][s8_ + 4], SC[mt_][s8_ + 5]), pkbf(SC[mt_][s8_ + 6], SC[mt_][s8_ + 7])})
#define BFR(v_) __uint_as_float(pkbf((v_), 0.f) << 16)
    bf16x8 kxf[2];
#pragma unroll
    for (int mt = 0; mt < 2; ++mt) { const float fj = (float)(32 * mt + krow); u32x4 w; w.x = pkbf(fj, fj); w.y = pkbf(1.0f, 1.0f); w.z = pkbf(1.0f, 0.f); w.w = 0u; if (hi) w = (u32x4){0u, 0u, 0u, 0u}; kxf[mt] = __builtin_bit_cast(bf16x8, w); }
    const float s1_ = BFR(slope2), s2_ = BFR(slope2 - s1_);
    const unsigned sc_pos = pkbf(s1_, s2_), sc_neg = pkbf(-s1_, -s2_);
#define MKQX(X_, w0_) ({ const float X__ = (X_); const float x1_ = BFR(X__); const float r1_ = X__ - x1_; const float x2_ = BFR(r1_); const float x3_ = r1_ - x2_; \
        u32x4 w_; w_.x = (w0_); w_.y = pkbf(x1_, x2_); w_.z = pkbf(x3_, 0.f); w_.w = 0u; if (hi) w_ = (u32x4){0u, 0u, 0u, 0u}; __builtin_bit_cast(bf16x8, w_); })
    f32x16 SA[2], SB_[2];
    { const int t0 = TILE_OF(0), t1 = TILE_OF(1);
      DMA_K(lds, t0); DMA_V(lds, t0);
      DMA_K(lds + STAGE_B, t1);
      DRAIN_BAR();
      asm volatile("" : "+v"(qf[0]), "+v"(qf[1]), "+v"(qf[2]), "+v"(qf[3]));
#pragma unroll
      for (int mt = 0; mt < 2; ++mt) { SA[mt] = f32x16{};
#pragma unroll
          for (int ks = 0; ks < 4; ++ks) SA[mt] = MFMA32(KFRAG(lds, mt, ks), qf[ks], SA[mt]); }
      const float qrel = (float)(qpos - 64 * t0 - 8 * hi);
#pragma unroll
      for (int mt = 0; mt < 2; ++mt)
#pragma unroll
          for (int r = 0; r < 16; ++r) PA_EL(SA, mt, r);
      asm volatile("s_waitcnt lgkmcnt(0)\n\ts_barrier" ::: "memory");
    }
#define SBAR() __builtin_amdgcn_sched_barrier(0)
#define STEP(SC, SN, i_, GEN, PAR) { const int i = (i_);        \
        LAS3 unsigned char* stc = lds + (PAR) * STAGE_B; LAS3 unsigned char* stn = lds + (1 - (PAR)) * STAGE_B; \
        const int t1 = TILE_OF(i + 1); \
        if (i + 2 < nt) { const int t2 = TILE_OF(i + 2); DMA_K(stc, t2); }        \
        DMA_V(stn, t1);                                                            \
        float ls = 0.f; bf16x8 pf[4]; bf16x8 vfA[4], vfB[4]; bf16x8 kf[8]; \
        _Pragma("unroll") for (int j = 0; j < 4; ++j) kf[j] = KFRAG(stn, j & 1, j >> 1); \
        if (!(GEN)) { const bool left_ = t1 < tc0; const int qr_ = qpos - 64 * t1; const bf16x8 qxf = MKQX(-slope2 * (float)(left_ ? qr_ : -qr_), (left_ ? sc_pos : sc_neg)); \
            SN[0] = MFMA32(kxf[0], qxf, f32x16{}); PB_EL(SC, 0, 0); PB_EL(SC, 0, 1); SBAR(); \
            SN[1] = MFMA32(kxf[1], qxf, f32x16{}); PB_EL(SC, 0, 2); PB_EL(SC, 0, 3); SBAR(); \
        } else { PB_EL(SC, 0, 0); PB_EL(SC, 0, 1); PB_EL(SC, 0, 2); PB_EL(SC, 0, 3); SBAR(); } \
        _Pragma("unroll") for (int j = 0; j < 8; ++j) { const int mt = j & 1, ks = j >> 1; \
            if (j == 0) { _Pragma("unroll") for (int j2 = 4; j2 < 8; ++j2) kf[j2] = KFRAG(stn, j2 & 1, j2 >> 1); } \
            if (j == 4) { _Pragma("unroll") for (int dt = 0; dt < 4; ++dt) vfA[dt] = VFRAG(stc, dt, 0); } \
            SN[mt] = MFMA32(kf[j], qf[ks], (((GEN) && ks == 0) ? f32x16{} : SN[mt])); \
            if (j < 6) { PB_EL(SC, 0, 4 + 2 * j); PB_EL(SC, 0, 5 + 2 * j); } \
            if (j == 1) pf[0] = PACK8(SC, 0, 0); \
            if (j == 5) pf[1] = PACK8(SC, 0, 8); \
            SBAR(); } \
        const float qrel = (float)(qpos - 64 * t1 - 8 * hi); \
        _Pragma("unroll") for (int g = 0; g < 4; ++g) { \
            _Pragma("unroll") for (int dt = 0; dt < 4; ++dt) { const int s_ = 4 * g + dt; \
                if (dt == 0 && g < 3) { _Pragma("unroll") for (int d2 = 0; d2 < 4; ++d2) { if (g & 1) vfA[d2] = VFRAG(stc, d2, g + 1); else vfB[d2] = VFRAG(stc, d2, g + 1); } } \
                o[dt] = MFMA32(((g & 1) ? vfB[dt] : vfA[dt]), pf[g], o[dt]); \
                if (s_ < 4) { PB_EL(SC, 1, 2 * s_); PB_EL(SC, 1, 2 * s_ + 1); if (s_ == 3) pf[2] = PACK8(SC, 1, 0); } \
                else if (s_ < 12) { PB_EL(SC, 1, 4 + s_); if (s_ == 11) pf[3] = PACK8(SC, 1, 8); } \
                if (GEN) { PA_EL(SN, (s_ >> 3), 2 * (s_ & 7)); PA_EL(SN, (s_ >> 3), 2 * (s_ & 7) + 1); } \
                SBAR(); } } \
        l += ls; \
        DRAIN_BAR(); }
#define TAIL(SC, i_) { const int i = (i_); LAS3 unsigned char* stc = lds + (i & 1) * STAGE_B; float ls = 0.f; bf16x8 pf[4]; \
        _Pragma("unroll") for (int mt = 0; mt < 2; ++mt) { _Pragma("unroll") for (int r = 0; r < 16; ++r) PB_EL(SC, mt, r); pf[2 * mt] = PACK8(SC, mt, 0); pf[2 * mt + 1] = PACK8(SC, mt, 8); } \
        l += ls; SBAR(); \
        _Pragma("unroll") for (int kk = 0; kk < 4; ++kk) { bf16x8 vf[4]; _Pragma("unroll") for (int dt = 0; dt < 4; ++dt) vf[dt] = VFRAG(stc, dt, kk); \
            _Pragma("unroll") for (int dt = 0; dt < 4; ++dt) o[dt] = MFMA32(vf[dt], pf[kk], o[dt]); SBAR(); } \
        asm volatile("s_waitcnt vmcnt(0) lgkmcnt(0)\n\ts_barrier" ::: "memory"); }
    STEP(SA, SB_, 0, true, 0);
    SA[0] = SB_[0]; SA[1] = SB_[1];
    int ii = 1;
    for (; ii + 2 < nt; ii += 2) {
        STEP(SA, SB_, ii, false, 1);
        STEP(SB_, SA, ii + 1, false, 0);
    }
    if (ii + 1 < nt) {
        STEP(SA, SB_, ii, false, 1);
        SA[0] = SB_[0]; SA[1] = SB_[1];
    }
    TAIL(SA, nt - 1);
#undef TAIL
#undef STEP
#undef SBAR
#undef DMA16
#undef DMA_K
#undef DMA_V
#undef DRAIN_BAR
#undef BFR
#undef MKQX
#undef PACK8
#undef PA_EL
#undef PB_EL
#undef VFRAG
#undef KFRAG
#undef MFMA32
#undef TILE_OF
    l += __shfl_xor(l, 32);
    const float inv = 1.0f / l;
    LAS3 float* xch = (LAS3 float*)(lds + XCH_OFF) + wq * 4096 + lane;
    if (strm == 1) {
#pragma unroll
        for (int dt = 0; dt < 4; ++dt)
#pragma unroll
            for (int r = 0; r < 16; ++r) xch[(dt * 16 + r) * 64] = o[dt][r] * inv;
    }
    __syncthreads();
    if (strm == 0) {
        float ss = 0.f;
#pragma unroll
        for (int dt = 0; dt < 4; ++dt)
#pragma unroll
            for (int r = 0; r < 16; ++r) { const float v = o[dt][r] * inv - P.lam * xch[(dt * 16 + r) * 64]; o[dt][r] = v; ss += v * v; }
        ss += __shfl_xor(ss, 32);
        const float rs = rsqrtf(ss * (1.0f / 128.0f) + NORM_EPS) * 0.8f;
        const size_t rowoff = ((size_t)b * S + qpos) * 1024 + h * 128;
#pragma unroll
        for (int dt = 0; dt < 4; ++dt)
#pragma unroll
            for (int rg = 0; rg < 4; ++rg) { const int d0 = 32 * dt + 8 * rg + 4 * hi;
                const f32x4 gs = *(const f32x4*)(P.gsub + d0); const u32x2 zw = *(const u32x2*)(P.ZS + rowoff + d0);
                u32x2 w; w.x = pkbf(o[dt][4 * rg] * rs * gs[0] * bflo(zw.x), o[dt][4 * rg + 1] * rs * gs[1] * bfhi(zw.x));
                w.y = pkbf(o[dt][4 * rg + 2] * rs * gs[2] * bflo(zw.y), o[dt][4 * rg + 3] * rs * gs[3] * bfhi(zw.y));
                *(u32x2*)(P.Y + rowoff + d0) = w; }
    }
}

constexpr int DB_ML = 65536, DB_WV = 67584;
__device__ __forceinline__ void dil_block(int item, LAS3 unsigned char* lds, const AttnP& P) {
    int tid_ = threadIdx.x; asm volatile("" : "+v"(tid_));
    const int lane = tid_ & 63, r32 = lane & 31, hi = lane >> 5; const int wid = __builtin_amdgcn_readfirstlane(tid_ >> 6);
    const int b = item >> 7, hh = (item >> 4) & 7, T0 = (item & 15) * 512;
    const float slope2 = __builtin_amdgcn_exp2f(-(float)(hh + 1)) * LOG2E;
    const bf16_t* Qh = P.QB + (size_t)(b * 8 + hh) * S * 64 + 8 * hi;
    const bf16_t* Kh = P.KB + (size_t)(b * 8 + hh) * S * 64 + (lane & 7) * 8;
    const bf16_t* Vh = P.VB + (size_t)(b * 8 + hh) * S * 64 + (lane & 7) * 8;
    const int krow = perm23(r32);
    LAS3 unsigned char* wlds = lds + (wid < 7 ? DB_WV + wid * 8192 : 135168);
    const int kfo = 4096 + krow * 128, kfx = (krow >> 1) & 7;
    int wv[4], wk[4], va[2][2];
#pragma unroll
    for (int i = 0; i < 4; ++i) { wv[i] = offv((lane >> 3) + 8 * i, lane & 7); wk[i] = swz((lane >> 3) + 8 * i, lane & 7); }
    { const int blk = (lane >> 4) & 1, q = (lane & 15) >> 2, pp = lane & 3;
#pragma unroll
      for (int t = 0; t < 2; ++t)
#pragma unroll
          for (int dt = 0; dt < 2; ++dt) va[t][dt] = offv(8 * hi + 4 * t + q, 4 * dt + 2 * blk + (pp >> 1)) + 8 * (pp & 1); }
#define GPARAMS(g_, pt_, dsh_, cls_, i0_, nb_, it_) { const int tk_ = (g_) / 5; it_ = (g_) - 5 * tk_; pt_ = tk_ >> 1; dsh_ = 2 * pt_; const int k_ = wid + 8 * (tk_ & 1); \
        cls_ = k_ & ((1 << dsh_) - 1); i0_ = (T0 >> dsh_) + 32 * (k_ >> dsh_); const int tt_ = (it_ == 0) ? 2 : (it_ <= 2 ? it_ - 1 : it_); nb_ = i0_ - 64 + 32 * tt_; }
#define GLOADT(dsh_, cls_, nb_) { const int nmax_ = (S >> (dsh_)) - 1; int nk_ = (nb_) + krow; nk_ = nk_ < 0 ? 0 : (nk_ > nmax_ ? nmax_ : nk_); \
        (void)nk_; \
        _Pragma("unroll") for (int i = 0; i < 4; ++i) { int nv_ = (nb_) + (lane >> 3) + 8 * i; nv_ = nv_ < 0 ? 0 : (nv_ > nmax_ ? nmax_ : nv_); const size_t ro_ = (size_t)((cls_) + (nv_ << (dsh_))) * 64; \
            krN[i] = *(const u32x4*)(Kh + ro_); vrN[i] = *(const u32x4*)(Vh + ro_); } }
#define GLOADQ(dsh_, cls_, i0_) { const bf16_t* qg_ = Qh + (size_t)((cls_) + (((i0_) + r32) << (dsh_))) * 64; \
        _Pragma("unroll") for (int ks = 0; ks < 4; ++ks) qfN[ks] = *(const bf16x8*)(qg_ + 16 * ks); }
    bf16x8 qfN[4], qf[4]; u32x4 krN[4], vrN[4];
    int ptc, dshc, clsc, i0c, nbc, itc;
    GPARAMS(0, ptc, dshc, clsc, i0c, nbc, itc);
    GLOADQ(dshc, clsc, i0c); GLOADT(dshc, clsc, nbc);
    f32x16 o[2]; o[0] = f32x16{}; o[1] = f32x16{};
    float l = 0.f;
#pragma nounroll
    for (int g = 0; g < 30; ++g) {
        u32x4 kr[4], vr[4];
#pragma unroll
        for (int i = 0; i < 4; ++i) { kr[i] = krN[i]; vr[i] = vrN[i]; }
        const int pt = ptc, dsh = dshc, cls = clsc, i0 = i0c, nbase = nbc, it = itc;
        if (it == 0) {
#pragma unroll
            for (int i = 0; i < 4; ++i) qf[i] = qfN[i];
            o[0] = f32x16{}; o[1] = f32x16{}; l = 0.f; }
        if (g + 1 < 30) { GPARAMS(g + 1, ptc, dshc, clsc, i0c, nbc, itc); GLOADT(dshc, clsc, nbc); if (itc == 0) GLOADQ(dshc, clsc, i0c); }
        const int qidx = i0 + r32, qpos = cls + (qidx << dsh), pr = qpos - T0;
        const float slope_d = slope2 * (float)(1 << dsh);
        {
            const bool tile_ok = (nbase >= 0 && nbase < (S >> dsh));
#pragma unroll
            for (int i = 0; i < 4; ++i) { *(LAS3 u32x4*)(wlds + 4096 + wk[i]) = kr[i]; *(LAS3 u32x4*)(wlds + wv[i]) = vr[i]; }
            bf16x8 ka[4];
#pragma unroll
            for (int ks = 0; ks < 4; ++ks) ka[ks] = *(const LAS3 bf16x8*)(wlds + kfo + (((2 * ks + hi) ^ kfx) << 4));
            f32x16 p = f32x16{};
#pragma unroll
            for (int ks = 0; ks < 4; ++ks) p = __builtin_amdgcn_mfma_f32_32x32x16_bf16(ka[ks], qf[ks], p, 0, 0, 0);
            const float base = (float)(nbase + 8 * hi - qidx), lim = tile_ok ? 64.0f : -1.0f;
            float ls = 0.f;
            if (tile_ok && (it == 0 || it == 2 || it == 3)) {
#pragma unroll
                for (int r = 0; r < 16; ++r) { const float ad = __builtin_fabsf(base + (float)((r & 7) + 16 * (r >> 3))); p[r] = __builtin_amdgcn_exp2f(__builtin_fmaf(-slope_d, ad, p[r])); ls += p[r]; }
            } else {
#pragma unroll
                for (int r = 0; r < 16; ++r) { const float ad = __builtin_fabsf(base + (float)((r & 7) + 16 * (r >> 3))); const float sv = __builtin_fmaf(-slope_d, ad, p[r]); p[r] = __builtin_amdgcn_exp2f((ad <= lim) ? sv : NEG_BIG); ls += p[r]; }
            }
            l += ls;
            bf16x8 pf[2];
#pragma unroll
            for (int s = 0; s < 2; ++s) { u32x4 w; w.x = pkbf(p[8 * s], p[8 * s + 1]); w.y = pkbf(p[8 * s + 2], p[8 * s + 3]); w.z = pkbf(p[8 * s + 4], p[8 * s + 5]); w.w = pkbf(p[8 * s + 6], p[8 * s + 7]); pf[s] = __builtin_bit_cast(bf16x8, w); }
#pragma unroll
            for (int dt = 0; dt < 2; ++dt)
#pragma unroll
                for (int s = 0; s < 2; ++s) { const bf16x8 av = cat8(vtr(wlds + va[0][dt] + 2048 * s), vtr(wlds + va[1][dt] + 2048 * s)); o[dt] = __builtin_amdgcn_mfma_f32_32x32x16_bf16(av, pf[s], o[dt], 0, 0, 0); }
        }
        if (it == 4) {
            l += __shfl_xor(l, 32);
            LAS3 unsigned char* orow = lds + pr * 128; const int sw = (pr ^ (pr >> 4)) & 15;
            LAS3 float* ml = (LAS3 float*)(lds + DB_ML) + pr - 1;
            if (pt > 0) {
                l += ml[1];
#pragma unroll
                for (int dt = 0; dt < 2; ++dt)
#pragma unroll
                    for (int rg = 0; rg < 4; ++rg) { const u32x2 w = *(const LAS3 u32x2*)(orow + (((8 * dt + 2 * rg + hi) ^ sw) << 3));
                        o[dt][4 * rg] += bflo(w.x); o[dt][4 * rg + 1] += bfhi(w.x); o[dt][4 * rg + 2] += bflo(w.y); o[dt][4 * rg + 3] += bfhi(w.y); }
            }
            if (pt < 2) {
                if (hi == 0) ml[1] = l;
#pragma unroll
                for (int dt = 0; dt < 2; ++dt)
#pragma unroll
                    for (int rg = 0; rg < 4; ++rg) { u32x2 w; w.x = pkbf(o[dt][4 * rg], o[dt][4 * rg + 1]); w.y = pkbf(o[dt][4 * rg + 2], o[dt][4 * rg + 3]); *(LAS3 u32x2*)(orow + (((8 * dt + 2 * rg + hi) ^ sw) << 3)) = w; }
            } else {
                const float inv = 1.0f / l;
                const size_t rowoff = ((size_t)b * S + qpos) * 1024 + 512 + hh * 64;
#pragma unroll
                for (int dt = 0; dt < 2; ++dt)
#pragma unroll
                    for (int rg = 0; rg < 4; ++rg) { const int d0 = 32 * dt + 8 * rg + 4 * hi; const u32x2 zw = *(const u32x2*)(P.ZS + rowoff + d0);
                        u32x2 w; w.x = pkbf(o[dt][4 * rg] * inv * bflo(zw.x), o[dt][4 * rg + 1] * inv * bfhi(zw.x)); w.y = pkbf(o[dt][4 * rg + 2] * inv * bflo(zw.y), o[dt][4 * rg + 3] * inv * bfhi(zw.y));
                        *(u32x2*)(P.Y + rowoff + d0) = w; }
            }
            if (g == 9 || g == 19 || g == 29) __syncthreads();
        }
    }
#undef GLOADQ
#undef GLOADT
#undef GPARAMS
}
}

#define GAS __attribute__((address_space(1)))
#define LAS __attribute__((address_space(3)))
typedef unsigned short bf16;
typedef unsigned v4u __attribute__((ext_vector_type(4)));
typedef float f32x4 __attribute__((ext_vector_type(4)));
constexpr int NWAVES = 8;
constexpr int BATCH = 2, T = 8192, DM = 1024, M = BATCH * T, NIN = 4096, PLE = 256;
constexpr int LDS_BYTES = 147456;
constexpr int N_DIFF_ITEMS = 512, N_DIL_ITEMS = 256;
constexpr int CW_BAR = 1024;
#define RLX_AGENT __ATOMIC_RELAXED, __HIP_MEMORY_SCOPE_AGENT
#define XB_TMO      128
#define XB_XCNT(j)  (256  + 64 * (j))
#define XB_XSUB(j)  (1280 + 64 * (j))
#define XB_XGEN(j)  (2304 + 64 * (j))
#define XB_TOP      3328
#define XB_TOPGEN   3392
#define XCD_BAR_WORDS 3456
#define XB_SPIN_CAP (1u << 18)

__device__ __forceinline__ unsigned xb_ld(unsigned* p)              { return __hip_atomic_load(p, __ATOMIC_RELAXED, __HIP_MEMORY_SCOPE_AGENT); }
__device__ __forceinline__ unsigned xb_add(unsigned* p, unsigned v) { return __hip_atomic_fetch_add(p, v, __ATOMIC_RELAXED, __HIP_MEMORY_SCOPE_AGENT); }
__device__ __forceinline__ unsigned xb_xcc_id() { return (unsigned)__builtin_amdgcn_s_getreg((3 << 11) | 20) & 0xFu; }
#define XB_SPIN(cond, bar) do { unsigned _sp = 0; while (cond) { __builtin_amdgcn_s_sleep(1); \
    if ((++_sp & 255u) == 0u) { if (xb_ld(&(bar)[XB_TMO])) break; if (_sp > XB_SPIN_CAP) { atomicAdd(&(bar)[XB_TMO], 1u); break; } } } } while (0)

struct XcdBarrier {
    unsigned* bar; unsigned x;
    volatile LAS unsigned* st;
};

__device__ __forceinline__ XcdBarrier xcd_barrier_post(unsigned* bar, volatile LAS unsigned* st) {
    XcdBarrier b; b.bar = bar; b.x = xb_xcc_id(); b.st = st;
    if (threadIdx.x == 0) (void)xb_add(&bar[XB_XCNT(b.x)], 1u);
    return b;
}
__device__ __forceinline__ void xcd_barrier_complete(unsigned* bar, unsigned x, unsigned& nloc, unsigned& nx) {
    const unsigned G = gridDim.x * gridDim.y * gridDim.z;
    unsigned sum, cnt, mine, sp = 0u;
    for (;;) {
        sum = 0u; cnt = 0u; mine = 0u;
#pragma unroll
        for (unsigned j = 0; j < 16; ++j) { const unsigned c = xb_ld(&bar[XB_XCNT(j)]); sum += c; cnt += (c > 0u) ? 1u : 0u; mine = (j == x) ? c : mine; }
        if (sum == G) break;
        __builtin_amdgcn_s_sleep(1);
        if ((++sp & 255u) == 0u) { if (xb_ld(&bar[XB_TMO])) break; if (sp > XB_SPIN_CAP) { atomicAdd(&bar[XB_TMO], 1u); break; } }
    }
    nloc = mine > 0u ? mine : 1u; nx = cnt > 0u ? cnt : 1u;
}

__device__ __forceinline__ void xcd_barrier(const XcdBarrier& b) {
    asm volatile("s_waitcnt vmcnt(0)" ::: "memory");
    __syncthreads();
    if (threadIdx.x == 0) {
        unsigned* bar = b.bar;
        __builtin_amdgcn_s_waitcnt(0);
        unsigned nloc = b.st[0], nx = b.st[1];
        if (nloc == 0u) { xcd_barrier_complete(bar, b.x, nloc, nx); b.st[0] = nloc; b.st[1] = nx; }
        const unsigned old = xb_add(&bar[XB_XSUB(b.x)], 1u);
        const unsigned gen = old / nloc;
        if (old + 1u == (gen + 1u) * nloc) {
            __builtin_amdgcn_fence(__ATOMIC_RELEASE, "agent");
            asm volatile("s_waitcnt vmcnt(0)" ::: "memory");
            const unsigned og = xb_add(&bar[XB_TOP], 1u);
            const unsigned tg = og / nx;
            if (og + 1u == (tg + 1u) * nx) xb_add(&bar[XB_TOPGEN], 1u);
            else XB_SPIN(xb_ld(&bar[XB_TOPGEN]) == tg, bar);
            __builtin_amdgcn_fence(__ATOMIC_ACQUIRE, "agent");
            xb_add(&bar[XB_XGEN(b.x)], 1u);
            asm volatile("s_waitcnt vmcnt(0)" ::: "memory");
        } else {
            XB_SPIN(xb_ld(&bar[XB_XGEN(b.x)]) == gen, bar);
            __builtin_amdgcn_fence(__ATOMIC_ACQUIRE, "agent");
            asm volatile("s_waitcnt vmcnt(0)" ::: "memory");
        }
    }
    __syncthreads();
}


__device__ __forceinline__ float wave_sum(float v) {
#pragma unroll
    for (int o = 1; o < 64; o <<= 1) v += __shfl_xor(v, o);
    return v;
}
__device__ __forceinline__ float wave_max(float v) {
#pragma unroll
    for (int o = 1; o < 64; o <<= 1) v = fmaxf(v, __shfl_xor(v, o));
    return v;
}
__device__ __forceinline__ void p0_transpose_item(const float* W, int K, int N, bf16* WT, const float* gk, LAS float* scr, int item, int lane) {
    const int nblk = N / 32, kb = item / nblk, nb = item % nblk, k0 = 64 * kb, n0 = 32 * nb;
    const int R0 = (n0 & ~255) + 128 * ((n0 >> 5) & 1) + 32 * ((n0 >> 6) & 3);
    float wv_[32];
#pragma unroll
    for (int i = 0; i < 32; ++i) wv_[i] = __builtin_nontemporal_load(&W[(size_t)(k0 + 2 * i + (lane >> 5)) * N + n0 + (lane & 31)]);
    if (gk) {
#pragma unroll
        for (int i = 0; i < 32; ++i) wv_[i] *= gk[k0 + 2 * i + (lane >> 5)];
    }
#pragma unroll
    for (int i = 0; i < 32; ++i) scr[(2 * i + (lane >> 5)) * 33 + (lane & 31)] = wv_[i];
    asm volatile("s_waitcnt lgkmcnt(0)" ::: "memory");
    const int c = lane & 7;
#pragma unroll
    for (int j = 0; j < 4; ++j) { const int n = (lane >> 3) + 8 * j; const LAS float* s = scr + (8 * c) * 33 + n;
        v4u o; o.x = pg8::pkbf(s[0 * 33], s[1 * 33]); o.y = pg8::pkbf(s[2 * 33], s[3 * 33]); o.z = pg8::pkbf(s[4 * 33], s[5 * 33]); o.w = pg8::pkbf(s[6 * 33], s[7 * 33]);
        const int rho = 16 * ((n >> 2) & 1) + 4 * (n >> 3) + (n & 3);
        *(v4u*)(WT + (size_t)(R0 + rho) * K + k0 + 8 * c) = o; }
    asm volatile("s_waitcnt lgkmcnt(0)" ::: "memory");
}

struct Args { const float* in[17]; float* out; unsigned char* ws; };

__global__ void __launch_bounds__(NWAVES * 64, 2) hymba_fwd(Args args) {
    extern __shared__ __attribute__((aligned(16))) unsigned char lds_raw[];
    cg::grid_group grid = cg::this_grid();
    LAS unsigned char* lds = (LAS unsigned char*)lds_raw;
    const int tid = threadIdx.x, lane = tid & 63, wave = __builtin_amdgcn_readfirstlane(tid >> 6);
    const int G = gridDim.x;
    unsigned char* ws = args.ws;
    const float* x = args.in[0]; const float* pin = args.in[1]; const float* g_mix = args.in[2]; const float* w_in = args.in[3];
    const float* g_dq = args.in[4]; const float* g_dk = args.in[5];
    const float* lq1 = args.in[6]; const float* lk1 = args.in[7]; const float* lq2 = args.in[8]; const float* lk2 = args.in[9];
    const float* g_sub = args.in[10]; const float* g_bq = args.in[11]; const float* g_bk = args.in[12];
    const float* w_out = args.in[13]; const float* g_ple = args.in[14]; const float* w_pg = args.in[15]; const float* w_pp = args.in[16];
    float* out = args.out;
    bf16* WIN = (bf16*)(ws + WS_WIN); bf16* WOUT = (bf16*)(ws + WS_WOUT); bf16* WPG = (bf16*)(ws + WS_WPG); bf16* WPP = (bf16*)(ws + WS_WPP);
    bf16* XN = (bf16*)(ws + WS_XN); bf16* PB = (bf16*)(ws + WS_PB); bf16* Y = XN;
    bf16* QD = (bf16*)(ws + WS_QD); bf16* KD = (bf16*)(ws + WS_KD); bf16* VD = (bf16*)(ws + WS_VD);
    bf16* QB = (bf16*)(ws + WS_QB); bf16* KB = (bf16*)(ws + WS_KB); bf16* VB = (bf16*)(ws + WS_VB);
    bf16* ZS = (bf16*)(ws + WS_ZS); bf16* X1B = ZS; bf16* PP = (bf16*)(ws + WS_PP);
    float* SSQ = (float*)(ws + WS_SSQ);
    unsigned* ctl = (unsigned*)(ws + WS_CTL);

    if (tid < 32) ((LAS unsigned*)(lds + 131072))[tid] = 0u;
    __syncthreads();
    const XcdBarrier bar = xcd_barrier_post(ctl + CW_BAR, (volatile LAS unsigned*)(lds + 131072 + 32));
    if (ws == nullptr) grid.sync();
    {
        int tl0_ = threadIdx.x; asm volatile("" : "+v"(tl0_)); const int lane = tl0_ & 63;
        if (blockIdx.x == 0 && wave == 0) { float* gt = (float*)(ws + WS_GAINS); gt[lane] = g_dq[lane] * pg8::QSCALE; gt[64 + lane] = g_dk[lane]; gt[128 + lane] = g_bq[lane] * pg8::QSCALE; gt[192 + lane] = g_bk[lane]; }
        LAS float* scr = (LAS float*)(lds + wave * 16384);
        const int gw = blockIdx.x * NWAVES + wave, NGW = G * NWAVES;
        constexpr int I_IN = (DM / 64) * (NIN / 32), I_SQ = (DM / 64) * (DM / 32), I_PP = (PLE / 64) * (DM / 32);
        constexpr int NITEMS = I_IN + 2 * I_SQ + I_PP;
        for (int it = gw; it < NITEMS; it += NGW) {
            int r = it;
            if (r < I_IN) { p0_transpose_item(w_in, DM, NIN, WIN, nullptr, scr, r, lane); continue; } r -= I_IN;
            if (r < I_SQ) { p0_transpose_item(w_out, DM, DM, WOUT, nullptr, scr, r, lane); continue; } r -= I_SQ;
            if (r < I_SQ) { p0_transpose_item(w_pg, DM, DM, WPG, g_ple, scr, r, lane); continue; } r -= I_SQ;
            p0_transpose_item(w_pp, PLE, DM, WPP, nullptr, scr, r, lane);
        }
        for (int m0 = gw; m0 < M; m0 += 2 * NGW) {
            const int m1 = (m0 + NGW < M) ? m0 + NGW : m0;
            const f32x4* xr0 = (const f32x4*)(x + (size_t)m0 * DM) + lane; const f32x4* xr1 = (const f32x4*)(x + (size_t)m1 * DM) + lane; const f32x4* gr = (const f32x4*)g_mix + lane;
            f32x4 v0[4], v1[4]; float s0 = 0.f, s1 = 0.f;
#pragma unroll
            for (int j = 0; j < 4; ++j) { v0[j] = xr0[64 * j]; v1[j] = xr1[64 * j]; }
            const f32x4 pv0 = __builtin_nontemporal_load((const f32x4*)(pin + (size_t)m0 * PLE) + lane), pv1 = __builtin_nontemporal_load((const f32x4*)(pin + (size_t)m1 * PLE) + lane);
#pragma unroll
            for (int j = 0; j < 4; ++j) { s0 += pg8::dot4(v0[j]); s1 += pg8::dot4(v1[j]); }
            const float rs0 = rsqrtf(wave_sum(s0) * (1.0f / DM) + pg8::NORM_EPS), rs1 = rsqrtf(wave_sum(s1) * (1.0f / DM) + pg8::NORM_EPS);
            unsigned long long* o80 = (unsigned long long*)(XN + (size_t)m0 * DM) + lane; unsigned long long* o81 = (unsigned long long*)(XN + (size_t)m1 * DM) + lane;
#pragma unroll
            for (int j = 0; j < 4; ++j) { const f32x4 gg = gr[64 * j]; const f32x4 w0 = v0[j] * rs0 * gg, w1 = v1[j] * rs1 * gg;
                o80[64 * j] = (unsigned long long)pg8::pkbf(w0[0], w0[1]) | ((unsigned long long)pg8::pkbf(w0[2], w0[3]) << 32);
                o81[64 * j] = (unsigned long long)pg8::pkbf(w1[0], w1[1]) | ((unsigned long long)pg8::pkbf(w1[2], w1[3]) << 32); }
            *((unsigned long long*)(PB + (size_t)m0 * PLE) + lane) = (unsigned long long)pg8::pkbf(pv0[0], pv0[1]) | ((unsigned long long)pg8::pkbf(pv0[2], pv0[3]) << 32);
            *((unsigned long long*)(PB + (size_t)m1 * PLE) + lane) = (unsigned long long)pg8::pkbf(pv1[0], pv1[1]) | ((unsigned long long)pg8::pkbf(pv1[2], pv1[3]) << 32);
        }
    }
    xcd_barrier(bar);

    {
        pg8::Gemm g{XN, WIN, M, NIN, DM}; pg8::StaticOrder So; So.init(M, NIN, G, (int)blockIdx.x);
        pg8::EpiIn E{ws, (const float*)(ws + WS_GAINS)};
        pg8::gemm_phase<pg8::EpiIn, pg8::StaticOrder, true, true>(lds, g, So, E);
        pg8::Gemm g2{PB, WPP, M, DM, PLE}; pg8::StaticOrder S2; S2.init(M, DM, G, (int)blockIdx.x);
        pg8::EpiPlain E2{PP, DM};
        pg8::gemm_phase<pg8::EpiPlain, pg8::StaticOrder, true, true>(lds, g2, S2, E2);
    }
    xcd_barrier(bar);

    {
        int tl_ = threadIdx.x; asm volatile("" : "+v"(tl_)); const int lane = tl_ & 63, tid = tl_;
        att::AttnP P; P.QD = QD; P.KD = KD; P.VD = VD; P.QB = QB; P.KB = KB; P.VB = VB; P.ZS = ZS; P.Y = Y; P.gsub = g_sub;
        const float s1 = wave_sum(lq1[lane] * lk1[lane]), s2 = wave_sum(lq2[lane] * lk2[lane]);
        P.lam = __expf(s1) - __expf(s2) + 0.2f;
        const float mq = wave_max(fabsf(g_dq[lane])), mk = wave_max(fabsf(g_dk[lane]));
        const float bound = 2.0f * (8.0f * mq * mk * 1.02f) + 25.0f;
#pragma unroll
        for (int h = 0; h < 4; ++h) { const float d = ceilf(bound * (float)(4 << (2 * h))); P.Dh[h] = __builtin_amdgcn_readfirstlane(d > 16384.f ? 16384 : (int)d); }
        LAS int* qslot = (LAS int*)(lds + 131072 + 64);
        for (;;) {
            if (tid == 0) *qslot = (int)atomicAdd(ctl, 1u);
            __syncthreads();
            const int it = __builtin_amdgcn_readfirstlane(*qslot);
            __syncthreads();
            if (it >= N_DIFF_ITEMS + N_DIL_ITEMS) break;
            if (it < 256) att::diff_item(it, lds, P);
            else if (it < 256 + N_DIL_ITEMS) {
                if (tid == 0) { const unsigned q0_ = xb_xcc_id() & 7u; int item_ = 0;
                    for (unsigned q_ = 0; q_ < 8u; ++q_) { const unsigned hq_ = (q0_ + q_) & 7u; const unsigned j_ = atomicAdd(ctl + 64 * (1 + hq_), 1u);
                        if (j_ < 32u) { item_ = (int)(((j_ >> 4) << 7) | (hq_ << 4) | (j_ & 15u)); break; } }
                    qslot[1] = item_; }
                __syncthreads();
                const int ditem = __builtin_amdgcn_readfirstlane(qslot[1]);
                att::dil_block(ditem, lds, P);
            }
            else att::diff_item(it - N_DIL_ITEMS, lds, P);
        }
    }
    xcd_barrier(bar);

    {
        pg8::Gemm g{Y, WOUT, M, DM, DM}; pg8::StaticOrder So; So.init(M, DM, G, (int)blockIdx.x);
        pg8::EpiRes E{x, X1B, SSQ};
        pg8::gemm_phase<pg8::EpiRes, pg8::StaticOrder, true, true>(lds, g, So, E);
    }
    xcd_barrier(bar);

    {
        pg8::Gemm g{X1B, WPG, M, DM, DM}; pg8::StaticOrder So; So.init(M, DM, G, (int)blockIdx.x);
        pg8::EpiGate E{out, X1B, PP, SSQ};
        pg8::gemm_phase<pg8::EpiGate, pg8::StaticOrder, true, true>(lds, g, So, E);
    }
}

extern "C" void kernel_launch(void* const* d_in, const int* in_sizes, int n_in, void* d_out, int out_size, void* d_ws, size_t ws_size, hipStream_t stream) {
    static int grid = 0;
    if (grid == 0) {
        if (n_in != 17 || out_size != M * DM || ws_size < WS_END) { fprintf(stderr, "kernel_launch: unexpected problem shape (n_in %d, out %d, ws %zu)\n", n_in, out_size, ws_size); grid = -1; return; }
        int dev = 0, cus = 0, per_cu = 0;
        hipGetDevice(&dev); hipDeviceGetAttribute(&cus, hipDeviceAttributeMultiprocessorCount, dev);
        if (hipFuncSetAttribute((const void*)hymba_fwd, hipFuncAttributeMaxDynamicSharedMemorySize, LDS_BYTES) != hipSuccess) { fprintf(stderr, "kernel_launch: hipFuncSetAttribute failed\n"); grid = -1; return; }
        if (hipOccupancyMaxActiveBlocksPerMultiprocessor(&per_cu, (const void*)hymba_fwd, NWAVES * 64, LDS_BYTES) != hipSuccess || per_cu < 1) { fprintf(stderr, "kernel_launch: occupancy query gave %d\n", per_cu); per_cu = 1; }
        (void)hipGetLastError();
        grid = cus * per_cu;
    }
    if (grid < 0) return;
    (void)hipMemsetAsync((char*)d_ws + WS_CTL, 0, CTL_ZERO_BYTES, stream);
    Args a{};
    for (int i = 0; i < 17; ++i) a.in[i] = (const float*)d_in[i];
    a.out = (float*)d_out; a.ws = (unsigned char*)d_ws;
    void* kargs[] = {&a};
    const hipError_t e = hipLaunchCooperativeKernel((const void*)hymba_fwd, dim3(grid), dim3(NWAVES * 64), kargs, LDS_BYTES, stream);
    if (e != hipSuccess) fprintf(stderr, "kernel_launch: cooperative launch failed: %s (grid %d)\n", hipGetErrorString(e), grid);
}
```

```cpp
#include <hip/hip_runtime.h>
#include <hip/hip_cooperative_groups.h>
#include <cstdio>
#include <cstdint>
namespace cg = cooperative_groups;
constexpr size_t MiB = 1u << 20;
constexpr size_t WS_CTL = 0, CTL_ZERO_BYTES = 32768, WS_GAINS = 65536, WS_SSQ = 1 * MiB;
constexpr size_t WS_WIN = 2 * MiB, WS_WOUT = 10 * MiB, WS_WPG = 12 * MiB, WS_WPP = 14 * MiB;
constexpr size_t WS_XN = 16 * MiB;
constexpr size_t WS_PB = 48 * MiB;
constexpr size_t WS_QD = 56 * MiB, WS_KD = 72 * MiB, WS_VD = 88 * MiB, WS_QB = 104 * MiB, WS_KB = 120 * MiB, WS_VB = 136 * MiB;
constexpr size_t WS_ZS = 184 * MiB;
constexpr size_t WS_PP = 216 * MiB, WS_END = 248 * MiB;
namespace pg8 {
#define PG8_LAS __attribute__((address_space(3)))
typedef unsigned short bf16_t;
typedef short bf16x8 __attribute__((ext_vector_type(8)));
typedef float f32x4 __attribute__((ext_vector_type(4)));
typedef unsigned u32x4 __attribute__((ext_vector_type(4)));
constexpr int BM = 256, BK = 64, HALF = 128, HTB = HALF * BK * 2  , STAGE_BYTES = 8 * HTB, NXCD = 8, WGM = 8;

__host__ __device__ __forceinline__ int lds_byte(int r, int c) { const int st = (r >> 4) * 2 + (c >> 5), rr = r & 15, cc = c & 31, ob = rr * 64 + cc * 2; return st * 1024 + (ob ^ (((ob >> 9) & 1) << 5)); }
__host__ __device__ __forceinline__ void stage_rc(int b, int& R, int& C) { const int st = b / 1024, sb = b % 1024, swz = sb ^ (((sb >> 9) & 1) << 5); R = (st >> 1) * 16 + swz / 64; C = (st & 1) * 32 + (swz % 64) / 2; }
__host__ __device__ __forceinline__ int perm32(int rho) { const int n = rho >> 4, i = rho & 15; return 8 * (i >> 2) + 4 * n + (i & 3); }

struct Unit { int pm, pn; };
struct Gemm { const bf16_t* A; const bf16_t* Bt; int M, N, K; };

struct StaticOrder {
    int nM, nN, nwg, G, c;
    __host__ __device__ void init(int M, int N, int G_, int c_) { nM = M / BM; nN = N / BM; nwg = nM * nN; G = G_; c = c_; }
    __host__ __device__ bool next(int i, Unit& u) const {
        const long L = (long)i * G + c; if (L >= nwg) return false;
        int wgid = (int)L; { const int q = nwg / NXCD, r = nwg % NXCD, xcd = wgid % NXCD, off = wgid / NXCD; wgid = (xcd < r ? xcd * (q + 1) : r * (q + 1) + (xcd - r) * q) + off; }
        const int nig = WGM * nN, gid = wgid / nig, fm = gid * WGM, gsz = (nM - fm) < WGM ? (nM - fm) : WGM;
        u.pm = fm + ((wgid % nig) % gsz); u.pn = (wgid % nig) / gsz; return true;
    }
    __device__ __forceinline__ void a_ready(const Unit&) const {}
    __device__ __forceinline__ void done(const Unit&) const {}
};
typedef unsigned u32x2 __attribute__((ext_vector_type(2)));
typedef float f32x2 __attribute__((ext_vector_type(2)));
typedef __bf16 bf16x2_t __attribute__((ext_vector_type(2)));
constexpr float LOG2E = 1.4426950408889634f;
constexpr float QSCALE = 0.125f * LOG2E;
constexpr float NORM_EPS = 1e-6f;
constexpr int SEQ = 8192;
__device__ __forceinline__ unsigned pkbf(float lo, float hi) { f32x2 v = {lo, hi}; bf16x2_t b = __builtin_convertvector(v, bf16x2_t); return __builtin_bit_cast(unsigned, b); }
__device__ __forceinline__ bf16_t f2bf(float v) { return (bf16_t)(pkbf(v, 0.f) & 0xffffu); }
__device__ __forceinline__ float bflo(unsigned w) { return __uint_as_float(w << 16); }
__device__ __forceinline__ float bfhi(unsigned w) { return __uint_as_float(w & 0xffff0000u); }
__device__ __forceinline__ float dot4(f32x4 v) { return (v[0] * v[0] + v[1] * v[1]) + (v[2] * v[2] + v[3] * v[3]); }
__device__ __forceinline__ float silu_f(float z) { return z * __builtin_amdgcn_rcpf(1.0f + __expf(-z)); }
__device__ __forceinline__ float sigm_f(float z) { return __builtin_amdgcn_rcpf(1.0f + __expf(-z)); }

typedef unsigned u32x4 __attribute__((ext_vector_type(4)));
__device__ __forceinline__ u32x4 pk8(f32x4 a, f32x4 b) { u32x4 w; w.x = pkbf(a[0], a[1]); w.y = pkbf(a[2], a[3]); w.z = pkbf(b[0], b[1]); w.w = pkbf(b[2], b[3]); return w; }
__device__ __forceinline__ f32x4 silu4(f32x4 v) { return (f32x4){silu_f(v[0]), silu_f(v[1]), silu_f(v[2]), silu_f(v[3])}; }
struct EpiIn {
    static constexpr bool PERM = false, AFTER_DRAIN = false;
    unsigned char* ws; const float* gains;
    __device__ __forceinline__ void operator()(const f32x4 (&acc)[2][2][4][2], const Unit& u, int wr, int wc, int fr, int fq) const {
        const int grp = u.pn * 4 + wc, kind = grp >> 3;
        const int rowb = u.pm * BM + wr * 64 + fr;
        if (kind == 0 || kind == 1 || kind == 3 || kind == 4) {
            const int gsel = kind < 2 ? kind : kind - 1;
            const float* g = gains + 64 * gsel + 8 * fq;
            bf16_t* dst = (bf16_t*)(ws + (kind == 0 ? WS_QD : kind == 1 ? WS_KD : kind == 3 ? WS_QB : WS_KB));
            const int gi = grp & 7;
            f32x4 gv[2][2];
#pragma unroll
            for (int bj = 0; bj < 2; ++bj)
#pragma unroll
                for (int n = 0; n < 2; ++n) gv[bj][n] = *(const f32x4*)(g + 32 * bj + 4 * n);
#pragma unroll
            for (int ai = 0; ai < 2; ++ai)
#pragma unroll
                for (int m = 0; m < 4; ++m) {
                    float ss = (dot4(acc[ai][0][m][0]) + dot4(acc[ai][0][m][1])) + (dot4(acc[ai][1][m][0]) + dot4(acc[ai][1][m][1]));
                    ss += __shfl_xor(ss, 16); ss += __shfl_xor(ss, 32);
                    const float rs = rsqrtf(ss * (1.0f / 64.0f) + NORM_EPS);
                    const int row = rowb + ai * HALF + m * 16, b = row >> 13, s = row & (SEQ - 1);
                    bf16_t* rp = dst + ((size_t)(b * 8 + gi) * SEQ + s) * 64 + 8 * fq;
#pragma unroll
                    for (int bj = 0; bj < 2; ++bj) *(u32x4*)(rp + 32 * bj) = pk8(acc[ai][bj][m][0] * rs * gv[bj][0], acc[ai][bj][m][1] * rs * gv[bj][1]);
                }
        } else {
            const bool isz = kind >= 6;
            int ld, coff; size_t boff, bstride;
            if (kind == 2) { const int gi = grp - 16; ld = 128; coff = 64 * (gi & 1); boff = WS_VD + (size_t)(gi >> 1) * SEQ * 128 * 2; bstride = (size_t)4 * SEQ * 128; }
            else if (kind == 5) { ld = 64; coff = 0; boff = WS_VB + (size_t)(grp - 40) * SEQ * 64 * 2; bstride = (size_t)8 * SEQ * 64; }
            else { ld = 1024; coff = 64 * (grp - 48); boff = WS_ZS; bstride = (size_t)SEQ * 1024; }
            bf16_t* base = (bf16_t*)(ws + boff) + coff + 8 * fq;
#pragma unroll
            for (int ai = 0; ai < 2; ++ai)
#pragma unroll
                for (int m = 0; m < 4; ++m) {
                    const int row = rowb + ai * HALF + m * 16, b = row >> 13, s = row & (SEQ - 1);
                    bf16_t* rp = base + (size_t)b * bstride + (size_t)s * ld;
#pragma unroll
                    for (int bj = 0; bj < 2; ++bj) { f32x4 v0 = acc[ai][bj][m][0], v1 = acc[ai][bj][m][1]; if (isz) { v0 = silu4(v0); v1 = silu4(v1); } *(u32x4*)(rp + 32 * bj) = pk8(v0, v1); }
                }
        }
    }
};
struct EpiPlain {
    static constexpr bool PERM = false, AFTER_DRAIN = false;
    bf16_t* O; int ldc;
    __device__ __forceinline__ void operator()(const f32x4 (&acc)[2][2][4][2], const Unit& u, int wr, int wc, int fr, int fq) const {
        const int rowb = u.pm * BM + wr * 64 + fr, cb = u.pn * BM + 64 * wc + 8 * fq;
#pragma unroll
        for (int ai = 0; ai < 2; ++ai)
#pragma unroll
            for (int m = 0; m < 4; ++m) { bf16_t* rp = O + (size_t)(rowb + ai * HALF + m * 16) * ldc + cb;
#pragma unroll
                for (int bj = 0; bj < 2; ++bj) *(u32x4*)(rp + 32 * bj) = pk8(acc[ai][bj][m][0], acc[ai][bj][m][1]); }
    }
};
struct EpiRes {
    static constexpr bool PERM = false, AFTER_DRAIN = false;
    const float* x; bf16_t* X1B; float* SSQ;
    __device__ __forceinline__ void operator()(const f32x4 (&acc)[2][2][4][2], const Unit& u, int wr, int wc, int fr, int fq) const {
        const int rowb = u.pm * BM + wr * 64 + fr, cb = u.pn * BM + 64 * wc + 8 * fq;
#pragma unroll
        for (int ai = 0; ai < 2; ++ai)
#pragma unroll
            for (int m = 0; m < 4; ++m) { const int row = rowb + ai * HALF + m * 16; const size_t off = (size_t)row * 1024 + cb; float ss = 0.f;
#pragma unroll
                for (int bj = 0; bj < 2; ++bj) { const f32x4 o0 = *(const f32x4*)(x + off + 32 * bj) + acc[ai][bj][m][0], o1 = *(const f32x4*)(x + off + 32 * bj + 4) + acc[ai][bj][m][1];
                    *(u32x4*)(X1B + off + 32 * bj) = pk8(o0, o1); ss += dot4(o0) + dot4(o1); }
                ss += __shfl_xor(ss, 16); ss += __shfl_xor(ss, 32);
                if (fq == 0) SSQ[(size_t)row * 16 + u.pn * 4 + wc] = ss; }
    }
};
struct EpiGate {
    static constexpr bool PERM = false, AFTER_DRAIN = false;
    float* out; const bf16_t* X1B; const bf16_t* PP; const float* SSQ;
    __device__ __forceinline__ void operator()(const f32x4 (&acc)[2][2][4][2], const Unit& u, int wr, int wc, int fr, int fq) const {
        const int rowb = u.pm * BM + wr * 64 + fr, cb = u.pn * BM + 64 * wc + 8 * fq;
#pragma unroll
        for (int ai = 0; ai < 2; ++ai)
#pragma unroll
            for (int m = 0; m < 4; ++m) { const int row = rowb + ai * HALF + m * 16; const size_t off = (size_t)row * 1024 + cb;
                const f32x4* sp = (const f32x4*)(SSQ + (size_t)row * 16); const f32x4 s0 = sp[0], s1 = sp[1], s2 = sp[2], s3 = sp[3];
                const float tot = ((s0[0] + s0[1]) + (s0[2] + s0[3])) + ((s1[0] + s1[1]) + (s1[2] + s1[3])) + ((s2[0] + s2[1]) + (s2[2] + s2[3])) + ((s3[0] + s3[1]) + (s3[2] + s3[3]));
                const float rs = rsqrtf(tot * (1.0f / 1024.0f) + NORM_EPS);
#pragma unroll
                for (int bj = 0; bj < 2; ++bj) { const f32x4 a0 = acc[ai][bj][m][0] * rs, a1 = acc[ai][bj][m][1] * rs; const u32x4 pw = *(const u32x4*)(PP + off + 32 * bj);
                    const u32x4 xw = *(const u32x4*)(X1B + off + 32 * bj); f32x4 o0 = (f32x4){bflo(xw.x), bfhi(xw.x), bflo(xw.y), bfhi(xw.y)}, o1 = (f32x4){bflo(xw.z), bfhi(xw.z), bflo(xw.w), bfhi(xw.w)};
                    o0[0] += sigm_f(a0[0]) * bflo(pw.x); o0[1] += sigm_f(a0[1]) * bfhi(pw.x); o0[2] += sigm_f(a0[2]) * bflo(pw.y); o0[3] += sigm_f(a0[3]) * bfhi(pw.y);
                    o1[0] += sigm_f(a1[0]) * bflo(pw.z); o1[1] += sigm_f(a1[1]) * bfhi(pw.z); o1[2] += sigm_f(a1[2]) * bflo(pw.w); o1[3] += sigm_f(a1[3]) * bfhi(pw.w);
                    __builtin_nontemporal_store(o0, (f32x4*)(out + off + 32 * bj)); __builtin_nontemporal_store(o1, (f32x4*)(out + off + 32 * bj + 4)); } }
    }
};

template <class Epi, class Sched, bool ALIGN_EPI = false, bool SP2 = false>
__device__ __forceinline__ void gemm_phase(PG8_LAS unsigned char* lds, const Gemm g, const Sched& S, const Epi& E) {
    int tid_ = threadIdx.x; asm volatile("" : "+v"(tid_));
    const int tid = tid_, wid = __builtin_amdgcn_readfirstlane(tid >> 6), lane = tid & 63, wr = wid >> 2, wc = wid & 3, fr = lane & 15, fq = lane >> 4;
    const int K = g.K, nt = K / BK;
    unsigned voffA[2], voffB[2];
#pragma unroll
    for (int i = 0; i < 2; ++i) { int R, C; stage_rc(tid * 16 + i * 8192, R, C); const int Rb = Epi::PERM ? ((R & ~31) + perm32(R & 31)) : R;
        voffA[i] = (unsigned)(R * K + C) * 2u; voffB[i] = (unsigned)(Rb * K + C) * 2u; }
    const size_t kstep = (size_t)(BK * 2);
    const size_t hstep = (size_t)HALF * K * 2;
    const size_t tstep = 2 * hstep;
    const unsigned ldsw = (unsigned)wid * 1024u;
    const int aoff = lds_byte(wr * 64 + fr, fq * 8), boff = lds_byte(wc * 32 + fr, fq * 8);
#define PG8_SA(b, h) (((b) * 2 + (h)) * HTB)
#define PG8_SB(b, h) ((4 + (b) * 2 + (h)) * HTB)
#define PG8_STAGE(bufoff, gbase, voff) do { _Pragma("unroll") for (int _i = 0; _i < 2; ++_i) \
        __builtin_amdgcn_global_load_lds((const unsigned*)((const char*)(gbase) + (voff)[_i]), (PG8_LAS unsigned*)(lds + (bufoff) + ldsw + _i * 8192), 16, 0, 0); } while (0)
#define PG8_LDA(dst, b, h) do { _Pragma("unroll") for (int m = 0; m < 4; ++m) _Pragma("unroll") for (int k = 0; k < 2; ++k) dst[m][k] = *(const PG8_LAS bf16x8*)(lds + PG8_SA(b, h) + aoff + m * 2048 + k * 1024); } while (0)
#define PG8_LDB(dst, b, h) do { _Pragma("unroll") for (int n = 0; n < 2; ++n) _Pragma("unroll") for (int k = 0; k < 2; ++k) dst[n][k] = *(const PG8_LAS bf16x8*)(lds + PG8_SB(b, h) + boff + n * 2048 + k * 1024); } while (0)
#define PG8_MMA(ai, bj, At, Bt) do { __builtin_amdgcn_s_setprio(1); _Pragma("unroll") for (int m = 0; m < 4; ++m) _Pragma("unroll") for (int n = 0; n < 2; ++n) _Pragma("unroll") for (int k = 0; k < 2; ++k) \
        acc[ai][bj][m][n] = __builtin_amdgcn_mfma_f32_16x16x32_bf16(Bt[n][k], At[m][k], acc[ai][bj][m][n], 0, 0, 0); __builtin_amdgcn_s_setprio(0); } while (0)
#define PG8_WAIT_V(n) asm volatile("s_waitcnt vmcnt(" #n ")" ::: "memory")
#define PG8_WAIT_L(n) asm volatile("s_waitcnt lgkmcnt(" #n ")" ::: "memory")
#define PG8_BAR __builtin_amdgcn_s_barrier()
#define PG8_SCHED __builtin_amdgcn_sched_barrier(0)
    Unit cur, nxt; int ui = 0;
    if (!S.next(0, cur)) return;
    f32x4 acc[2][2][4][2];
#pragma unroll
    for (int a = 0; a < 2; ++a)
#pragma unroll
        for (int b = 0; b < 2; ++b)
#pragma unroll
            for (int m = 0; m < 4; ++m)
#pragma unroll
                for (int n = 0; n < 2; ++n) acc[a][b][m][n] = (f32x4){0.f, 0.f, 0.f, 0.f};
    bf16x8 At[4][2], B0[2][2], B1[2][2];
    const char* cA = (const char*)g.A + (size_t)cur.pm * tstep; const char* cB = (const char*)g.Bt + (size_t)cur.pn * tstep;
    S.a_ready(cur);
    if constexpr (SP2) {
        PG8_STAGE(PG8_SB(0, 0), cB, voffB); PG8_STAGE(PG8_SB(0, 1), cB + hstep, voffB); PG8_STAGE(PG8_SA(0, 0), cA, voffA); PG8_STAGE(PG8_SA(0, 1), cA + hstep, voffA);
        if (wr == 1) PG8_BAR;
        PG8_WAIT_V(2); PG8_BAR;
        PG8_STAGE(PG8_SB(1, 0), cB + kstep, voffB); PG8_STAGE(PG8_SA(1, 0), cA + kstep, voffA); PG8_STAGE(PG8_SB(1, 1), cB + hstep + kstep, voffB);
        PG8_WAIT_V(6); PG8_BAR;
    } else {
        PG8_STAGE(PG8_SB(0, 0), cB, voffB); PG8_STAGE(PG8_SA(0, 0), cA, voffA); PG8_STAGE(PG8_SB(0, 1), cB + hstep, voffB); PG8_STAGE(PG8_SA(0, 1), cA + hstep, voffA);
        if (wr == 1) PG8_BAR;
        PG8_WAIT_V(4); PG8_BAR;
        PG8_STAGE(PG8_SB(1, 0), cB + kstep, voffB); PG8_STAGE(PG8_SA(1, 0), cA + kstep, voffA); PG8_STAGE(PG8_SB(1, 1), cB + hstep + kstep, voffB);
        PG8_WAIT_V(6); PG8_BAR;
    }
    for (;;) {
        const bool has_next = S.next(ui + 1, nxt);
        const char* nA = has_next ? (const char*)g.A + (size_t)nxt.pm * tstep : cA; const char* nB = has_next ? (const char*)g.Bt + (size_t)nxt.pn * tstep : cB;
        for (int t = 0; t < nt; t += 2) {
            const bool last = (t == nt - 2);
            const char* a1 = cA + (size_t)(t + 1) * kstep;
            const char* a2 = last ? nA : cA + (size_t)(t + 2) * kstep; const char* b2 = last ? nB : cB + (size_t)(t + 2) * kstep;
            const char* a3 = a2 + kstep; const char* b3 = b2 + kstep;
            if (last && has_next) S.a_ready(nxt);
            if constexpr (SP2) {
            PG8_LDB(B0, 0, 0); PG8_LDB(B1, 0, 1); PG8_SCHED; PG8_LDA(At, 0, 0); PG8_STAGE(PG8_SA(1, 1), a1 + hstep, voffA);
            PG8_WAIT_V(8); PG8_WAIT_L(0); PG8_BAR; PG8_MMA(0, 0, At, B0); PG8_MMA(0, 1, At, B1); PG8_BAR; PG8_SCHED;
            PG8_LDA(At, 0, 1); PG8_STAGE(PG8_SB(0, 0), b2, voffB); PG8_STAGE(PG8_SB(0, 1), b2 + hstep, voffB); PG8_STAGE(PG8_SA(0, 0), a2, voffA);
            PG8_WAIT_V(8); PG8_WAIT_L(0); PG8_BAR; PG8_MMA(1, 0, At, B0); PG8_MMA(1, 1, At, B1); PG8_BAR; PG8_SCHED;
            PG8_LDB(B0, 1, 0); PG8_LDB(B1, 1, 1); PG8_SCHED; PG8_LDA(At, 1, 0); PG8_STAGE(PG8_SA(0, 1), a2 + hstep, voffA);
            PG8_WAIT_V(8); PG8_WAIT_L(0); PG8_BAR; PG8_MMA(0, 0, At, B0); PG8_MMA(0, 1, At, B1); PG8_BAR; PG8_SCHED;
            PG8_LDA(At, 1, 1); PG8_STAGE(PG8_SB(1, 0), b3, voffB); PG8_STAGE(PG8_SB(1, 1), b3 + hstep, voffB); PG8_STAGE(PG8_SA(1, 0), a3, voffA);
            PG8_WAIT_V(8); PG8_WAIT_L(0); PG8_BAR; PG8_MMA(1, 0, At, B0); PG8_MMA(1, 1, At, B1); PG8_BAR; PG8_SCHED;
            } else {
            PG8_LDB(B0, 0, 0); PG8_SCHED; PG8_LDA(At, 0, 0); PG8_STAGE(PG8_SA(1, 1), a1 + hstep, voffA);
            PG8_WAIT_L(8); PG8_BAR; PG8_WAIT_L(0); PG8_MMA(0, 0, At, B0); PG8_BAR; PG8_SCHED;
            PG8_LDB(B1, 0, 1); PG8_STAGE(PG8_SB(0, 0), b2, voffB);
            PG8_BAR; PG8_WAIT_L(0); PG8_MMA(0, 1, At, B1); PG8_BAR;
            PG8_LDA(At, 0, 1); PG8_STAGE(PG8_SA(0, 0), a2, voffA);
            PG8_BAR; PG8_WAIT_L(0); PG8_MMA(1, 0, At, B0); PG8_BAR; PG8_SCHED;
            PG8_STAGE(PG8_SB(0, 1), b2 + hstep, voffB);
            PG8_WAIT_V(6); PG8_BAR; PG8_MMA(1, 1, At, B1); PG8_BAR;
            PG8_LDB(B0, 1, 0); PG8_SCHED; PG8_LDA(At, 1, 0); PG8_STAGE(PG8_SA(0, 1), a2 + hstep, voffA);
            PG8_WAIT_L(8); PG8_BAR; PG8_WAIT_L(0); PG8_MMA(0, 0, At, B0); PG8_BAR; PG8_SCHED;
            PG8_LDB(B1, 1, 1); PG8_STAGE(PG8_SB(1, 0), b3, voffB);
            PG8_BAR; PG8_WAIT_L(0); PG8_MMA(0, 1, At, B1); PG8_BAR;
            PG8_LDA(At, 1, 1); PG8_STAGE(PG8_SA(1, 0), a3, voffA);
            PG8_BAR; PG8_WAIT_L(0); PG8_MMA(1, 0, At, B0); PG8_BAR; PG8_SCHED;
            PG8_STAGE(PG8_SB(1, 1), b3 + hstep, voffB);
            PG8_WAIT_V(6); PG8_BAR; PG8_MMA(1, 1, At, B1); PG8_BAR;
            }
        }
        if constexpr (ALIGN_EPI) { if (wr == 0) PG8_BAR; }
        if constexpr (!Epi::AFTER_DRAIN) { int t2 = tid; asm volatile("" : "+v"(t2)); const int l2 = t2 & 63, w2 = __builtin_amdgcn_readfirstlane(t2 >> 6); E(acc, cur, w2 >> 2, w2 & 3, l2 & 15, l2 >> 4); S.done(cur); }
        if (!has_next) break;
#pragma unroll
        for (int a = 0; a < 2; ++a)
#pragma unroll
            for (int b = 0; b < 2; ++b)
#pragma unroll
                for (int m = 0; m < 4; ++m)
#pragma unroll
                    for (int n = 0; n < 2; ++n) acc[a][b][m][n] = (f32x4){0.f, 0.f, 0.f, 0.f};
        cur = nxt; cA = nA; cB = nB; ++ui;
        if constexpr (ALIGN_EPI) { if (wr == 1) PG8_BAR; }
    }
    PG8_WAIT_V(0);
    if constexpr (!ALIGN_EPI) { if (wr == 0) PG8_BAR; }
    PG8_BAR;
    if constexpr (Epi::AFTER_DRAIN) { E.fused(acc, cur, wr, wc, fr, fq, lds, wid, lane); S.done(cur); }
#undef PG8_SA
#undef PG8_SB
#undef PG8_STAGE
#undef PG8_LDA
#undef PG8_LDB
#undef PG8_MMA
#undef PG8_WAIT_V
#undef PG8_WAIT_L
#undef PG8_BAR
#undef PG8_SCHED
}
}

namespace att {
#define LAS3 __attribute__((address_space(3)))
typedef unsigned short bf16_t;
typedef short bf16x8 __attribute__((ext_vector_type(8)));
typedef float f32x16 __attribute__((ext_vector_type(16)));
typedef float f32x4 __attribute__((ext_vector_type(4)));
typedef unsigned u32x4 __attribute__((ext_vector_type(4)));
typedef unsigned u32x2 __attribute__((ext_vector_type(2)));
using pg8::pkbf; using pg8::bflo; using pg8::bfhi; using pg8::LOG2E; using pg8::NORM_EPS;
constexpr int S = 8192;
constexpr int STAGE_B = 32768;
constexpr int XCH_OFF = 65536;
constexpr float NEG_BIG = -30000.0f;
struct AttnP { const bf16_t *QD, *KD, *VD, *QB, *KB, *VB, *ZS; bf16_t* Y; const float* gsub; float lam; int Dh[4]; };

__device__ __forceinline__ int swz(int row, int c) { return row * 128 + ((c ^ ((row >> 1) & 7)) << 4); }
typedef short v4i16_t __attribute__((ext_vector_type(4)));
__device__ __forceinline__ v4i16_t vtr(const LAS3 unsigned char* p) { return __builtin_amdgcn_ds_read_tr16_b64_v4i16((LAS3 v4i16_t*)p); }
__device__ __forceinline__ bf16x8 cat8(v4i16_t lo, v4i16_t hi4) { return (bf16x8){lo[0], lo[1], lo[2], lo[3], hi4[0], hi4[1], hi4[2], hi4[3]}; }
__device__ __forceinline__ int offb(int row, int ch) { return 256 * row + 16 * (ch ^ (((row & 3) << 2) | ((row >> 2) & 3))); }
__device__ __forceinline__ int offv(int row, int ch) { return 128 * row + 16 * (ch ^ (((row >> 1) & 1) << 2)); }
__device__ __forceinline__ void glds16(const void* sbase, unsigned voff, unsigned lds_dst) { unsigned keep;
    asm volatile("s_mov_b32 %0, m0\n\ts_mov_b32 m0, %3\n\ts_nop 0\n\tglobal_load_lds_dwordx4 %1, %2\n\ts_mov_b32 m0, %0" : "=&s"(keep) : "v"(voff), "s"(sbase), "s"(lds_dst) : "memory"); }
__device__ __forceinline__ int perm23(int r) { return (r & 0x13) | ((r & 4) << 1) | ((r & 8) >> 1); }

__device__ __forceinline__ void diff_item(int idx, LAS3 unsigned char* lds, const AttnP& P) {
    int tid_ = threadIdx.x; asm volatile("" : "+v"(tid_));
    const int tid = tid_, lane = tid & 63, r32 = lane & 31, hi = lane >> 5; const int wid = __builtin_amdgcn_readfirstlane(tid >> 6);
    const int strm = wid >> 2, wq = wid & 3;
    const int h = 3 - (idx >> 7), b = (idx >> 6) & 1, qb = idx & 63;
    const int q0 = qb * 128, qpos = q0 + wq * 32 + r32;
    const float slope2 = __builtin_amdgcn_exp2f(-2.0f * (float)(h + 1)) * LOG2E;
    const int D = h == 0 ? P.Dh[0] : h == 1 ? P.Dh[1] : h == 2 ? P.Dh[2] : P.Dh[3];
    int tlo = q0 - 63 - D; tlo = tlo <= 0 ? 0 : ((tlo + 63) >> 6);
    int thi = (q0 + 127 + D) >> 6; if (thi > S / 64 - 1) thi = S / 64 - 1;
    const int tc0 = 2 * qb, nl = tc0 - tlo, nr = thi - (tc0 + 1), nt = 2 + nl + nr;
#define TILE_OF(i) ((i) < 2 ? tc0 + (i) : ((tlo + (i) - 2) < tc0 ? (tlo + (i) - 2) : (tlo + (i))))
    const int kr_ = 8 * wid + (lane >> 3);
    const bf16_t* kb0 = P.KD + ((size_t)(b * 8 + 2 * h) * S) * 64; const bf16_t* kb1 = kb0 + (size_t)S * 64;
    const unsigned kof = (unsigned)(kr_ * 128 + (((lane & 7) ^ ((kr_ >> 1) & 7)) << 4));
    const int vr0_ = 4 * wid + (lane >> 4), vr1_ = 32 + vr0_;
    const bf16_t* vb = P.VD + ((size_t)(b * 4 + h) * S) * 128;
    const unsigned vof0 = (unsigned)(vr0_ * 256 + (((lane & 15) ^ (((vr0_ & 3) << 2) | ((vr0_ >> 2) & 3))) << 4));
    const unsigned vof1 = (unsigned)(vr1_ * 256 + (((lane & 15) ^ (((vr1_ & 3) << 2) | ((vr1_ >> 2) & 3))) << 4));
    const int dK = wid * 1024, dV0 = 16384 + wid * 1024, dV1 = 16384 + 8192 + wid * 1024;
#define DMA16(b_, o_, l_) glds16((b_), (o_), (unsigned)__builtin_amdgcn_readfirstlane((int)(unsigned)(uintptr_t)(l_)))
#define DMA_K(st_, t_) { const unsigned o_ = kof + (unsigned)(t_) * 8192u; DMA16(kb0, o_, (st_) + dK); DMA16(kb1, o_, (st_) + 8192 + dK); }
#define DMA_V(st_, t_) { const unsigned tb_ = (unsigned)(t_) * 16384u; DMA16(vb, vof0 + tb_, (st_) + dV0); DMA16(vb, vof1 + tb_, (st_) + dV1); }
#define DRAIN_BAR() asm volatile("s_waitcnt vmcnt(0) lgkmcnt(0)\n\ts_barrier" ::: "memory")
    bf16x8 qf[4];
    { const bf16_t* qg = P.QD + ((size_t)(b * 8 + 2 * h + strm) * S + qpos) * 64 + 8 * hi;
      asm volatile("global_load_dwordx4 %0, %4, off\n\tglobal_load_dwordx4 %1, %4, off offset:32\n\tglobal_load_dwordx4 %2, %4, off offset:64\n\tglobal_load_dwordx4 %3, %4, off offset:96"
                   : "=&v"(qf[0]), "=&v"(qf[1]), "=&v"(qf[2]), "=&v"(qf[3]) : "v"(qg) : "memory"); }
    const int krow = perm23(r32), kx = (krow >> 1) & 7;
    const int kbase = strm * 8192 + krow * 128;
    int va[2][4];
    { const int blk = (lane >> 4) & 1, q = (lane & 15) >> 2, pp = lane & 3;
#pragma unroll
      for (int t = 0; t < 2; ++t)
#pragma unroll
          for (int dt = 0; dt < 4; ++dt) va[t][dt] = 16384 + 256 * (8 * hi + 4 * t + q) + 16 * (((dt ^ q) << 2) | ((2 * blk + (pp >> 1)) ^ ((2 * hi + t) & 3))) + 8 * (pp & 1); }
    f32x16 o[4];
#pragma unroll
    for (int i = 0; i < 4; ++i) o[i] = f32x16{};
    float l = 0.f;
#define MFMA32(a_, b_, c_) __builtin_amdgcn_mfma_f32_32x32x16_bf16(a_, b_, c_, 0, 0, 0)
#define KFRAG(st_, mt_, ks_) (*(const LAS3 bf16x8*)((st_) + kbase + (mt_) * 4096 + (((2 * (ks_) + hi) ^ kx) << 4)))
#define VFRAG(st_, dt_, kk_) cat8(vtr((st_) + va[0][dt_] + 4096 * (kk_)), vtr((st_) + va[1][dt_] + 4096 * (kk_)))
#define PB_EL(SC, mt_, r_) { const float v_ = __builtin_amdgcn_exp2f(SC[mt_][r_]); SC[mt_][r_] = v_; ls += v_; }
#define PA_EL(SN, mt_, r_) { const float d_ = qrel - (float)(32 * (mt_) + ((r_) & 7) + 16 * ((r_) >> 3)); SN[mt_][r_] = __builtin_fmaf(-slope2, __builtin_fabsf(d_), SN[mt_][r_]); }
#define PACK8(SC, mt_, s8_) __builtin_bit_cast(bf16x8, (u32x4){pkbf(SC[mt_][s8_], SC[mt_][s8_ + 1]), pkbf(SC[mt_][s8_ + 2], SC[mt_][s8_ + 3]), pkbf(SC[mt_][s8_ + 4], SC[mt_][s8_ + 5]), pkbf(SC[mt_][s8_ + 6], SC[mt_][s8_ + 7])})
#define BFR(v_) __uint_as_float(pkbf((v_), 0.f) << 16)
    bf16x8 kxf[2];
#pragma unroll
    for (int mt = 0; mt < 2; ++mt) { const float fj = (float)(32 * mt + krow); u32x4 w; w.x = pkbf(fj, fj); w.y = pkbf(1.0f, 1.0f); w.z = pkbf(1.0f, 0.f); w.w = 0u; if (hi) w = (u32x4){0u, 0u, 0u, 0u}; kxf[mt] = __builtin_bit_cast(bf16x8, w); }
    const float s1_ = BFR(slope2), s2_ = BFR(slope2 - s1_);
    const unsigned sc_pos = pkbf(s1_, s2_), sc_neg = pkbf(-s1_, -s2_);
#define MKQX(X_, w0_) ({ const float X__ = (X_); const float x1_ = BFR(X__); const float r1_ = X__ - x1_; const float x2_ = BFR(r1_); const float x3_ = r1_ - x2_; \
        u32x4 w_; w_.x = (w0_); w_.y = pkbf(x1_, x2_); w_.z = pkbf(x3_, 0.f); w_.w = 0u; if (hi) w_ = (u32x4){0u, 0u, 0u, 0u}; __builtin_bit_cast(bf16x8, w_); })
    f32x16 SA[2], SB_[2];
    { const int t0 = TILE_OF(0), t1 = TILE_OF(1);
      DMA_K(lds, t0); DMA_V(lds, t0);
      DMA_K(lds + STAGE_B, t1);
      DRAIN_BAR();
      asm volatile("" : "+v"(qf[0]), "+v"(qf[1]), "+v"(qf[2]), "+v"(qf[3]));
#pragma unroll
      for (int mt = 0; mt < 2; ++mt) { SA[mt] = f32x16{};
#pragma unroll
          for (int ks = 0; ks < 4; ++ks) SA[mt] = MFMA32(KFRAG(lds, mt, ks), qf[ks], SA[mt]); }
      const float qrel = (float)(qpos - 64 * t0 - 8 * hi);
#pragma unroll
      for (int mt = 0; mt < 2; ++mt)
#pragma unroll
          for (int r = 0; r < 16; ++r) PA_EL(SA, mt, r);
      asm volatile("s_waitcnt lgkmcnt(0)\n\ts_barrier" ::: "memory");
    }
#define SBAR() __builtin_amdgcn_sched_barrier(0)
#define STEP(SC, SN, i_, GEN, PAR) { const int i = (i_);        \
        LAS3 unsigned char* stc = lds + (PAR) * STAGE_B; LAS3 unsigned char* stn = lds + (1 - (PAR)) * STAGE_B; \
        const int t1 = TILE_OF(i + 1); \
        if (i + 2 < nt) { const int t2 = TILE_OF(i + 2); DMA_K(stc, t2); }        \
        DMA_V(stn, t1);                                                            \
        float ls = 0.f; bf16x8 pf[4]; bf16x8 vfA[4], vfB[4]; bf16x8 kf[8]; \
        _Pragma("unroll") for (int j = 0; j < 4; ++j) kf[j] = KFRAG(stn, j & 1, j >> 1); \
        if (!(GEN)) { const bool left_ = t1 < tc0; const int qr_ = qpos - 64 * t1; const bf16x8 qxf = MKQX(-slope2 * (float)(left_ ? qr_ : -qr_), (left_ ? sc_pos : sc_neg)); \
            SN[0] = MFMA32(kxf[0], qxf, f32x16{}); PB_EL(SC, 0, 0); PB_EL(SC, 0, 1); SBAR(); \
            SN[1] = MFMA32(kxf[1], qxf, f32x16{}); PB_EL(SC, 0, 2); PB_EL(SC, 0, 3); SBAR(); \
        } else { PB_EL(SC, 0, 0); PB_EL(SC, 0, 1); PB_EL(SC, 0, 2); PB_EL(SC, 0, 3); SBAR(); } \
        _Pragma("unroll") for (int j = 0; j < 8; ++j) { const int mt = j & 1, ks = j >> 1; \
            if (j == 0) { _Pragma("unroll") for (int j2 = 4; j2 < 8; ++j2) kf[j2] = KFRAG(stn, j2 & 1, j2 >> 1); } \
            if (j == 4) { _Pragma("unroll") for (int dt = 0; dt < 4; ++dt) vfA[dt] = VFRAG(stc, dt, 0); } \
            SN[mt] = MFMA32(kf[j], qf[ks], (((GEN) && ks == 0) ? f32x16{} : SN[mt])); \
            if (j < 6) { PB_EL(SC, 0, 4 + 2 * j); PB_EL(SC, 0, 5 + 2 * j); } \
            if (j == 1) pf[0] = PACK8(SC, 0, 0); \
            if (j == 5) pf[1] = PACK8(SC, 0, 8); \
            SBAR(); } \
        const float qrel = (float)(qpos - 64 * t1 - 8 * hi); \
        _Pragma("unroll") for (int g = 0; g < 4; ++g) { \
            _Pragma("unroll") for (int dt = 0; dt < 4; ++dt) { const int s_ = 4 * g + dt; \
                if (dt == 0 && g < 3) { _Pragma("unroll") for (int d2 = 0; d2 < 4; ++d2) { if (g & 1) vfA[d2] = VFRAG(stc, d2, g + 1); else vfB[d2] = VFRAG(stc, d2, g + 1); } } \
                o[dt] = MFMA32(((g & 1) ? vfB[dt] : vfA[dt]), pf[g], o[dt]); \
                if (s_ < 4) { PB_EL(SC, 1, 2 * s_); PB_EL(SC, 1, 2 * s_ + 1); if (s_ == 3) pf[2] = PACK8(SC, 1, 0); } \
                else if (s_ < 12) { PB_EL(SC, 1, 4 + s_); if (s_ == 11) pf[3] = PACK8(SC, 1, 8); } \
                if (GEN) { PA_EL(SN, (s_ >> 3), 2 * (s_ & 7)); PA_EL(SN, (s_ >> 3), 2 * (s_ & 7) + 1); } \
                SBAR(); } } \
        l += ls; \
        DRAIN_BAR(); }
#define TAIL(SC, i_) { const int i = (i_); LAS3 unsigned char* stc = lds + (i & 1) * STAGE_B; float ls = 0.f; bf16x8 pf[4]; \
        _Pragma("unroll") for (int mt = 0; mt < 2; ++mt) { _Pragma("unroll") for (int r = 0; r < 16; ++r) PB_EL(SC, mt, r); pf[2 * mt] = PACK8(SC, mt, 0); pf[2 * mt + 1] = PACK8(SC, mt, 8); } \
        l += ls; SBAR(); \
        _Pragma("unroll") for (int kk = 0; kk < 4; ++kk) { bf16x8 vf[4]; _Pragma("unroll") for (int dt = 0; dt < 4; ++dt) vf[dt] = VFRAG(stc, dt, kk); \
            _Pragma("unroll") for (int dt = 0; dt < 4; ++dt) o[dt] = MFMA32(vf[dt], pf[kk], o[dt]); SBAR(); } \
        asm volatile("s_waitcnt vmcnt(0) lgkmcnt(0)\n\ts_barrier" ::: "memory"); }
    STEP(SA, SB_, 0, true, 0);
    SA[0] = SB_[0]; SA[1] = SB_[1];
    int ii = 1;
    for (; ii + 2 < nt; ii += 2) {
        STEP(SA, SB_, ii, false, 1);
        STEP(SB_, SA, ii + 1, false, 0);
    }
    if (ii + 1 < nt) {
        STEP(SA, SB_, ii, false, 1);
        SA[0] = SB_[0]; SA[1] = SB_[1];
    }
    TAIL(SA, nt - 1);
#undef TAIL
#undef STEP
#undef SBAR
#undef DMA16
#undef DMA_K
#undef DMA_V
#undef DRAIN_BAR
#undef BFR
#undef MKQX
#undef PACK8
#undef PA_EL
#undef PB_EL
#undef VFRAG
#undef KFRAG
#undef MFMA32
#undef TILE_OF
    l += __shfl_xor(l, 32);
    const float inv = 1.0f / l;
    LAS3 float* xch = (LAS3 float*)(lds + XCH_OFF) + wq * 4096 + lane;
    if (strm == 1) {
#pragma unroll
        for (int dt = 0; dt < 4; ++dt)
#pragma unroll
            for (int r = 0; r < 16; ++r) xch[(dt * 16 + r) * 64] = o[dt][r] * inv;
    }
    __syncthreads();
    if (strm == 0) {
        float ss = 0.f;
#pragma unroll
        for (int dt = 0; dt < 4; ++dt)
#pragma unroll
            for (int r = 0; r < 16; ++r) { const float v = o[dt][r] * inv - P.lam * xch[(dt * 16 + r) * 64]; o[dt][r] = v; ss += v * v; }
        ss += __shfl_xor(ss, 32);
        const float rs = rsqrtf(ss * (1.0f / 128.0f) + NORM_EPS) * 0.8f;
        const size_t rowoff = ((size_t)b * S + qpos) * 1024 + h * 128;
#pragma unroll
        for (int dt = 0; dt < 4; ++dt)
#pragma unroll
            for (int rg = 0; rg < 4; ++rg) { const int d0 = 32 * dt + 8 * rg + 4 * hi;
                const f32x4 gs = *(const f32x4*)(P.gsub + d0); const u32x2 zw = *(const u32x2*)(P.ZS + rowoff + d0);
                u32x2 w; w.x = pkbf(o[dt][4 * rg] * rs * gs[0] * bflo(zw.x), o[dt][4 * rg + 1] * rs * gs[1] * bfhi(zw.x));
                w.y = pkbf(o[dt][4 * rg + 2] * rs * gs[2] * bflo(zw.y), o[dt][4 * rg + 3] * rs * gs[3] * bfhi(zw.y));
                *(u32x2*)(P.Y + rowoff + d0) = w; }
    }
}

constexpr int DB_ML = 65536, DB_WV = 67584;
__device__ __forceinline__ void dil_block(int item, LAS3 unsigned char* lds, const AttnP& P) {
    int tid_ = threadIdx.x; asm volatile("" : "+v"(tid_));
    const int lane = tid_ & 63, r32 = lane & 31, hi = lane >> 5; const int wid = __builtin_amdgcn_readfirstlane(tid_ >> 6);
    const int b = item >> 7, hh = (item >> 4) & 7, T0 = (item & 15) * 512;
    const float slope2 = __builtin_amdgcn_exp2f(-(float)(hh + 1)) * LOG2E;
    const bf16_t* Qh = P.QB + (size_t)(b * 8 + hh) * S * 64 + 8 * hi;
    const bf16_t* Kh = P.KB + (size_t)(b * 8 + hh) * S * 64 + (lane & 7) * 8;
    const bf16_t* Vh = P.VB + (size_t)(b * 8 + hh) * S * 64 + (lane & 7) * 8;
    const int krow = perm23(r32);
    LAS3 unsigned char* wlds = lds + (wid < 7 ? DB_WV + wid * 8192 : 135168);
    const int kfo = 4096 + krow * 128, kfx = (krow >> 1) & 7;
    int wv[4], wk[4], va[2][2];
#pragma unroll
    for (int i = 0; i < 4; ++i) { wv[i] = offv((lane >> 3) + 8 * i, lane & 7); wk[i] = swz((lane >> 3) + 8 * i, lane & 7); }
    { const int blk = (lane >> 4) & 1, q = (lane & 15) >> 2, pp = lane & 3;
#pragma unroll
      for (int t = 0; t < 2; ++t)
#pragma unroll
          for (int dt = 0; dt < 2; ++dt) va[t][dt] = offv(8 * hi + 4 * t + q, 4 * dt + 2 * blk + (pp >> 1)) + 8 * (pp & 1); }
#define DLOAD(nb_) { _Pragma("unroll") for (int i = 0; i < 4; ++i) { int nv_ = (nb_) + (lane >> 3) + 8 * i; nv_ = nv_ < 0 ? 0 : (nv_ > nmax ? nmax : nv_); const size_t ro_ = (size_t)(cls + (nv_ << dsh)) * 64; \
            krN[i] = *(const u32x4*)(Kh + ro_); vrN[i] = *(const u32x4*)(Vh + ro_); } }
#define DPASS(QF, O, L, QIDX) { f32x16 p = f32x16{}; \
        _Pragma("unroll") for (int ks = 0; ks < 4; ++ks) p = __builtin_amdgcn_mfma_f32_32x32x16_bf16(ka[ks], QF[ks], p, 0, 0, 0); \
        const float base = (float)(nbase + 8 * hi - (QIDX)); float ls = 0.f; \
        _Pragma("unroll") for (int r = 0; r < 16; ++r) { const float ad = __builtin_fabsf(base + (float)((r & 7) + 16 * (r >> 3))); const float sv = __builtin_fmaf(-slope_d, ad, p[r]); p[r] = __builtin_amdgcn_exp2f((ad <= lim) ? sv : NEG_BIG); ls += p[r]; } \
        L += ls; \
        bf16x8 pf[2]; \
        _Pragma("unroll") for (int s = 0; s < 2; ++s) { u32x4 w; w.x = pkbf(p[8 * s], p[8 * s + 1]); w.y = pkbf(p[8 * s + 2], p[8 * s + 3]); w.z = pkbf(p[8 * s + 4], p[8 * s + 5]); w.w = pkbf(p[8 * s + 6], p[8 * s + 7]); pf[s] = __builtin_bit_cast(bf16x8, w); } \
        _Pragma("unroll") for (int s = 0; s < 2; ++s) _Pragma("unroll") for (int dt = 0; dt < 2; ++dt) O[dt] = __builtin_amdgcn_mfma_f32_32x32x16_bf16(vfr[dt][s], pf[s], O[dt], 0, 0, 0); }
#define DMERGE(O, L, QIDX) { float l_ = L + __shfl_xor(L, 32); const int qpos = cls + ((QIDX) << dsh), pr = qpos - T0; \
        LAS3 unsigned char* orow = lds + pr * 128; const int sw = (pr ^ (pr >> 4)) & 15; LAS3 float* ml = (LAS3 float*)(lds + DB_ML) + pr; \
        if (pt > 0) { l_ += ml[0]; \
            _Pragma("unroll") for (int dt = 0; dt < 2; ++dt) _Pragma("unroll") for (int rg = 0; rg < 4; ++rg) { const u32x2 w = *(const LAS3 u32x2*)(orow + (((8 * dt + 2 * rg + hi) ^ sw) << 3)); \
                O[dt][4 * rg] += bflo(w.x); O[dt][4 * rg + 1] += bfhi(w.x); O[dt][4 * rg + 2] += bflo(w.y); O[dt][4 * rg + 3] += bfhi(w.y); } } \
        if (pt < 2) { if (hi == 0) ml[0] = l_; \
            _Pragma("unroll") for (int dt = 0; dt < 2; ++dt) _Pragma("unroll") for (int rg = 0; rg < 4; ++rg) { u32x2 w; w.x = pkbf(O[dt][4 * rg], O[dt][4 * rg + 1]); w.y = pkbf(O[dt][4 * rg + 2], O[dt][4 * rg + 3]); *(LAS3 u32x2*)(orow + (((8 * dt + 2 * rg + hi) ^ sw) << 3)) = w; } \
        } else { const float inv = 1.0f / l_; const size_t rowoff = ((size_t)b * S + qpos) * 1024 + 512 + hh * 64; \
            _Pragma("unroll") for (int dt = 0; dt < 2; ++dt) _Pragma("unroll") for (int rg = 0; rg < 4; ++rg) { const int d0 = 32 * dt + 8 * rg + 4 * hi; const u32x2 zw = *(const u32x2*)(P.ZS + rowoff + d0); \
                u32x2 w; w.x = pkbf(O[dt][4 * rg] * inv * bflo(zw.x), O[dt][4 * rg + 1] * inv * bfhi(zw.x)); w.y = pkbf(O[dt][4 * rg + 2] * inv * bflo(zw.y), O[dt][4 * rg + 3] * inv * bfhi(zw.y)); \
                *(u32x2*)(P.Y + rowoff + d0) = w; } } }
#pragma nounroll
    for (int run = 0; run < 4; ++run) {
        const int pt = run < 2 ? run : 2, dsh = 2 * pt, nmax = (S >> dsh) - 1;
        const bool hasB = run < 2;
        const int cls = pt == 0 ? 0 : (pt == 1 ? (wid & 3) : wid + 8 * (run - 2));
        const int i0 = pt == 0 ? T0 + 64 * wid : (pt == 1 ? (T0 >> 2) + 64 * (wid >> 2) : (T0 >> 4));
        const int ntile = hasB ? 6 : 5;
        const float slope_d = slope2 * (float)(1 << dsh);
        const int qidxA = i0 + r32, qidxB = i0 + 32 + r32;
        bf16x8 qfA[4], qfB[4]; u32x4 krN[4], vrN[4];
        { const bf16_t* qa = Qh + (size_t)(cls + (qidxA << dsh)) * 64; const bf16_t* qb_ = Qh + (size_t)(cls + ((hasB ? qidxB : qidxA) << dsh)) * 64;
#pragma unroll
          for (int ks = 0; ks < 4; ++ks) { qfA[ks] = *(const bf16x8*)(qa + 16 * ks); qfB[ks] = *(const bf16x8*)(qb_ + 16 * ks); } }
        DLOAD(i0 - 64);
        f32x16 oA[2], oB[2]; oA[0] = f32x16{}; oA[1] = f32x16{}; oB[0] = f32x16{}; oB[1] = f32x16{};
        float lA = 0.f, lB = 0.f;
#pragma nounroll
        for (int t = 0; t < ntile; ++t) {
            u32x4 kr[4], vr[4];
#pragma unroll
            for (int i = 0; i < 4; ++i) { kr[i] = krN[i]; vr[i] = vrN[i]; }
            const int nbase = i0 - 64 + 32 * t;
            if (t + 1 < ntile) DLOAD(nbase + 32);
            const bool tile_ok = (nbase >= 0 && nbase <= nmax); const float lim = tile_ok ? 64.0f : -1.0f;
#pragma unroll
            for (int i = 0; i < 4; ++i) { *(LAS3 u32x4*)(wlds + 4096 + wk[i]) = kr[i]; *(LAS3 u32x4*)(wlds + wv[i]) = vr[i]; }
            bf16x8 ka[4], vfr[2][2];
#pragma unroll
            for (int ks = 0; ks < 4; ++ks) ka[ks] = *(const LAS3 bf16x8*)(wlds + kfo + (((2 * ks + hi) ^ kfx) << 4));
#pragma unroll
            for (int dt = 0; dt < 2; ++dt)
#pragma unroll
                for (int s = 0; s < 2; ++s) vfr[dt][s] = cat8(vtr(wlds + va[0][dt] + 2048 * s), vtr(wlds + va[1][dt] + 2048 * s));
            if (t <= 4) DPASS(qfA, oA, lA, qidxA);
            if (hasB && t >= 1) DPASS(qfB, oB, lB, qidxB);
        }
        DMERGE(oA, lA, qidxA);
        if (hasB) DMERGE(oB, lB, qidxB);
        if (run != 2) __syncthreads();
    }
#undef DMERGE
#undef DPASS
#undef DLOAD
}
}

#define GAS __attribute__((address_space(1)))
#define LAS __attribute__((address_space(3)))
typedef unsigned short bf16;
typedef unsigned v4u __attribute__((ext_vector_type(4)));
typedef float f32x4 __attribute__((ext_vector_type(4)));
constexpr int NWAVES = 8;
constexpr int BATCH = 2, T = 8192, DM = 1024, M = BATCH * T, NIN = 4096, PLE = 256;
constexpr int LDS_BYTES = 147456;
constexpr int N_DIFF_ITEMS = 512, N_DIL_ITEMS = 256;
constexpr int CW_BAR = 1024;
#define RLX_AGENT __ATOMIC_RELAXED, __HIP_MEMORY_SCOPE_AGENT
#define XB_TMO      128
#define XB_XCNT(j)  (256  + 64 * (j))
#define XB_XSUB(j)  (1280 + 64 * (j))
#define XB_XGEN(j)  (2304 + 64 * (j))
#define XB_TOP      3328
#define XB_TOPGEN   3392
#define XCD_BAR_WORDS 3456
#define XB_SPIN_CAP (1u << 18)

__device__ __forceinline__ unsigned xb_ld(unsigned* p)              { return __hip_atomic_load(p, __ATOMIC_RELAXED, __HIP_MEMORY_SCOPE_AGENT); }
__device__ __forceinline__ unsigned xb_add(unsigned* p, unsigned v) { return __hip_atomic_fetch_add(p, v, __ATOMIC_RELAXED, __HIP_MEMORY_SCOPE_AGENT); }
__device__ __forceinline__ unsigned xb_xcc_id() { return (unsigned)__builtin_amdgcn_s_getreg((3 << 11) | 20) & 0xFu; }
#define XB_SPIN(cond, bar) do { unsigned _sp = 0; while (cond) { __builtin_amdgcn_s_sleep(1); \
    if ((++_sp & 255u) == 0u) { if (xb_ld(&(bar)[XB_TMO])) break; if (_sp > XB_SPIN_CAP) { atomicAdd(&(bar)[XB_TMO], 1u); break; } } } } while (0)

struct XcdBarrier {
    unsigned* bar; unsigned x;
    volatile LAS unsigned* st;
};

__device__ __forceinline__ XcdBarrier xcd_barrier_post(unsigned* bar, volatile LAS unsigned* st) {
    XcdBarrier b; b.bar = bar; b.x = xb_xcc_id(); b.st = st;
    if (threadIdx.x == 0) (void)xb_add(&bar[XB_XCNT(b.x)], 1u);
    return b;
}
__device__ __forceinline__ void xcd_barrier_complete(unsigned* bar, unsigned x, unsigned& nloc, unsigned& nx) {
    const unsigned G = gridDim.x * gridDim.y * gridDim.z;
    unsigned sum, cnt, mine, sp = 0u;
    for (;;) {
        sum = 0u; cnt = 0u; mine = 0u;
#pragma unroll
        for (unsigned j = 0; j < 16; ++j) { const unsigned c = xb_ld(&bar[XB_XCNT(j)]); sum += c; cnt += (c > 0u) ? 1u : 0u; mine = (j == x) ? c : mine; }
        if (sum == G) break;
        __builtin_amdgcn_s_sleep(1);
        if ((++sp & 255u) == 0u) { if (xb_ld(&bar[XB_TMO])) break; if (sp > XB_SPIN_CAP) { atomicAdd(&bar[XB_TMO], 1u); break; } }
    }
    nloc = mine > 0u ? mine : 1u; nx = cnt > 0u ? cnt : 1u;
}

__device__ __forceinline__ void xcd_barrier(const XcdBarrier& b) {
    asm volatile("s_waitcnt vmcnt(0)" ::: "memory");
    __syncthreads();
    if (threadIdx.x == 0) {
        unsigned* bar = b.bar;
        __builtin_amdgcn_s_waitcnt(0);
        unsigned nloc = b.st[0], nx = b.st[1];
        if (nloc == 0u) { xcd_barrier_complete(bar, b.x, nloc, nx); b.st[0] = nloc; b.st[1] = nx; }
        const unsigned old = xb_add(&bar[XB_XSUB(b.x)], 1u);
        const unsigned gen = old / nloc;
        if (old + 1u == (gen + 1u) * nloc) {
            __builtin_amdgcn_fence(__ATOMIC_RELEASE, "agent");
            asm volatile("s_waitcnt vmcnt(0)" ::: "memory");
            const unsigned og = xb_add(&bar[XB_TOP], 1u);
            const unsigned tg = og / nx;
            if (og + 1u == (tg + 1u) * nx) xb_add(&bar[XB_TOPGEN], 1u);
            else XB_SPIN(xb_ld(&bar[XB_TOPGEN]) == tg, bar);
            __builtin_amdgcn_fence(__ATOMIC_ACQUIRE, "agent");
            xb_add(&bar[XB_XGEN(b.x)], 1u);
            asm volatile("s_waitcnt vmcnt(0)" ::: "memory");
        } else {
            XB_SPIN(xb_ld(&bar[XB_XGEN(b.x)]) == gen, bar);
            __builtin_amdgcn_fence(__ATOMIC_ACQUIRE, "agent");
            asm volatile("s_waitcnt vmcnt(0)" ::: "memory");
        }
    }
    __syncthreads();
}


__device__ __forceinline__ float wave_sum(float v) {
#pragma unroll
    for (int o = 1; o < 64; o <<= 1) v += __shfl_xor(v, o);
    return v;
}
__device__ __forceinline__ float wave_max(float v) {
#pragma unroll
    for (int o = 1; o < 64; o <<= 1) v = fmaxf(v, __shfl_xor(v, o));
    return v;
}
__device__ __forceinline__ void p0_transpose_item(const float* W, int K, int N, bf16* WT, const float* gk, LAS float* scr, int item, int lane) {
    const int nblk = N / 32, kb = item / nblk, nb = item % nblk, k0 = 64 * kb, n0 = 32 * nb;
    const int R0 = (n0 & ~255) + 128 * ((n0 >> 5) & 1) + 32 * ((n0 >> 6) & 3);
    float wv_[32];
#pragma unroll
    for (int i = 0; i < 32; ++i) wv_[i] = __builtin_nontemporal_load(&W[(size_t)(k0 + 2 * i + (lane >> 5)) * N + n0 + (lane & 31)]);
    if (gk) {
#pragma unroll
        for (int i = 0; i < 32; ++i) wv_[i] *= gk[k0 + 2 * i + (lane >> 5)];
    }
#pragma unroll
    for (int i = 0; i < 32; ++i) scr[(2 * i + (lane >> 5)) * 33 + (lane & 31)] = wv_[i];
    asm volatile("s_waitcnt lgkmcnt(0)" ::: "memory");
    const int c = lane & 7;
#pragma unroll
    for (int j = 0; j < 4; ++j) { const int n = (lane >> 3) + 8 * j; const LAS float* s = scr + (8 * c) * 33 + n;
        v4u o; o.x = pg8::pkbf(s[0 * 33], s[1 * 33]); o.y = pg8::pkbf(s[2 * 33], s[3 * 33]); o.z = pg8::pkbf(s[4 * 33], s[5 * 33]); o.w = pg8::pkbf(s[6 * 33], s[7 * 33]);
        const int rho = 16 * ((n >> 2) & 1) + 4 * (n >> 3) + (n & 3);
        *(v4u*)(WT + (size_t)(R0 + rho) * K + k0 + 8 * c) = o; }
    asm volatile("s_waitcnt lgkmcnt(0)" ::: "memory");
}

struct Args { const float* in[17]; float* out; unsigned char* ws; };

__global__ void __launch_bounds__(NWAVES * 64, 2) hymba_fwd(Args args) {
    extern __shared__ __attribute__((aligned(16))) unsigned char lds_raw[];
    cg::grid_group grid = cg::this_grid();
    LAS unsigned char* lds = (LAS unsigned char*)lds_raw;
    const int tid = threadIdx.x, lane = tid & 63, wave = __builtin_amdgcn_readfirstlane(tid >> 6);
    const int G = gridDim.x;
    unsigned char* ws = args.ws;
    const float* x = args.in[0]; const float* pin = args.in[1]; const float* g_mix = args.in[2]; const float* w_in = args.in[3];
    const float* g_dq = args.in[4]; const float* g_dk = args.in[5];
    const float* lq1 = args.in[6]; const float* lk1 = args.in[7]; const float* lq2 = args.in[8]; const float* lk2 = args.in[9];
    const float* g_sub = args.in[10]; const float* g_bq = args.in[11]; const float* g_bk = args.in[12];
    const float* w_out = args.in[13]; const float* g_ple = args.in[14]; const float* w_pg = args.in[15]; const float* w_pp = args.in[16];
    float* out = args.out;
    bf16* WIN = (bf16*)(ws + WS_WIN); bf16* WOUT = (bf16*)(ws + WS_WOUT); bf16* WPG = (bf16*)(ws + WS_WPG); bf16* WPP = (bf16*)(ws + WS_WPP);
    bf16* XN = (bf16*)(ws + WS_XN); bf16* PB = (bf16*)(ws + WS_PB); bf16* Y = XN;
    bf16* QD = (bf16*)(ws + WS_QD); bf16* KD = (bf16*)(ws + WS_KD); bf16* VD = (bf16*)(ws + WS_VD);
    bf16* QB = (bf16*)(ws + WS_QB); bf16* KB = (bf16*)(ws + WS_KB); bf16* VB = (bf16*)(ws + WS_VB);
    bf16* ZS = (bf16*)(ws + WS_ZS); bf16* X1B = ZS; bf16* PP = (bf16*)(ws + WS_PP);
    float* SSQ = (float*)(ws + WS_SSQ);
    unsigned* ctl = (unsigned*)(ws + WS_CTL);

    if (tid < 32) ((LAS unsigned*)(lds + 131072))[tid] = 0u;
    __syncthreads();
    const XcdBarrier bar = xcd_barrier_post(ctl + CW_BAR, (volatile LAS unsigned*)(lds + 131072 + 32));
    if (ws == nullptr) grid.sync();
    {
        int tl0_ = threadIdx.x; asm volatile("" : "+v"(tl0_)); const int lane = tl0_ & 63;
        if (blockIdx.x == 0 && wave == 0) { float* gt = (float*)(ws + WS_GAINS); gt[lane] = g_dq[lane] * pg8::QSCALE; gt[64 + lane] = g_dk[lane]; gt[128 + lane] = g_bq[lane] * pg8::QSCALE; gt[192 + lane] = g_bk[lane]; }
        LAS float* scr = (LAS float*)(lds + wave * 16384);
        const int gw = blockIdx.x * NWAVES + wave, NGW = G * NWAVES;
        constexpr int I_IN = (DM / 64) * (NIN / 32), I_SQ = (DM / 64) * (DM / 32), I_PP = (PLE / 64) * (DM / 32);
        constexpr int NITEMS = I_IN + 2 * I_SQ + I_PP;
        for (int it = gw; it < NITEMS; it += NGW) {
            int r = it;
            if (r < I_IN) { p0_transpose_item(w_in, DM, NIN, WIN, nullptr, scr, r, lane); continue; } r -= I_IN;
            if (r < I_SQ) { p0_transpose_item(w_out, DM, DM, WOUT, nullptr, scr, r, lane); continue; } r -= I_SQ;
            if (r < I_SQ) { p0_transpose_item(w_pg, DM, DM, WPG, g_ple, scr, r, lane); continue; } r -= I_SQ;
            p0_transpose_item(w_pp, PLE, DM, WPP, nullptr, scr, r, lane);
        }
        for (int m0 = gw; m0 < M; m0 += 2 * NGW) {
            const int m1 = (m0 + NGW < M) ? m0 + NGW : m0;
            const f32x4* xr0 = (const f32x4*)(x + (size_t)m0 * DM) + lane; const f32x4* xr1 = (const f32x4*)(x + (size_t)m1 * DM) + lane; const f32x4* gr = (const f32x4*)g_mix + lane;
            f32x4 v0[4], v1[4]; float s0 = 0.f, s1 = 0.f;
#pragma unroll
            for (int j = 0; j < 4; ++j) { v0[j] = xr0[64 * j]; v1[j] = xr1[64 * j]; }
            const f32x4 pv0 = __builtin_nontemporal_load((const f32x4*)(pin + (size_t)m0 * PLE) + lane), pv1 = __builtin_nontemporal_load((const f32x4*)(pin + (size_t)m1 * PLE) + lane);
#pragma unroll
            for (int j = 0; j < 4; ++j) { s0 += pg8::dot4(v0[j]); s1 += pg8::dot4(v1[j]); }
            const float rs0 = rsqrtf(wave_sum(s0) * (1.0f / DM) + pg8::NORM_EPS), rs1 = rsqrtf(wave_sum(s1) * (1.0f / DM) + pg8::NORM_EPS);
            unsigned long long* o80 = (unsigned long long*)(XN + (size_t)m0 * DM) + lane; unsigned long long* o81 = (unsigned long long*)(XN + (size_t)m1 * DM) + lane;
#pragma unroll
            for (int j = 0; j < 4; ++j) { const f32x4 gg = gr[64 * j]; const f32x4 w0 = v0[j] * rs0 * gg, w1 = v1[j] * rs1 * gg;
                o80[64 * j] = (unsigned long long)pg8::pkbf(w0[0], w0[1]) | ((unsigned long long)pg8::pkbf(w0[2], w0[3]) << 32);
                o81[64 * j] = (unsigned long long)pg8::pkbf(w1[0], w1[1]) | ((unsigned long long)pg8::pkbf(w1[2], w1[3]) << 32); }
            *((unsigned long long*)(PB + (size_t)m0 * PLE) + lane) = (unsigned long long)pg8::pkbf(pv0[0], pv0[1]) | ((unsigned long long)pg8::pkbf(pv0[2], pv0[3]) << 32);
            *((unsigned long long*)(PB + (size_t)m1 * PLE) + lane) = (unsigned long long)pg8::pkbf(pv1[0], pv1[1]) | ((unsigned long long)pg8::pkbf(pv1[2], pv1[3]) << 32);
        }
    }
    xcd_barrier(bar);

    {
        pg8::Gemm g{XN, WIN, M, NIN, DM}; pg8::StaticOrder So; So.init(M, NIN, G, (int)blockIdx.x);
        pg8::EpiIn E{ws, (const float*)(ws + WS_GAINS)};
        pg8::gemm_phase<pg8::EpiIn, pg8::StaticOrder, true, true>(lds, g, So, E);
        pg8::Gemm g2{PB, WPP, M, DM, PLE}; pg8::StaticOrder S2; S2.init(M, DM, G, (int)blockIdx.x);
        pg8::EpiPlain E2{PP, DM};
        pg8::gemm_phase<pg8::EpiPlain, pg8::StaticOrder, true, true>(lds, g2, S2, E2);
    }
    xcd_barrier(bar);

    {
        int tl_ = threadIdx.x; asm volatile("" : "+v"(tl_)); const int lane = tl_ & 63, tid = tl_;
        att::AttnP P; P.QD = QD; P.KD = KD; P.VD = VD; P.QB = QB; P.KB = KB; P.VB = VB; P.ZS = ZS; P.Y = Y; P.gsub = g_sub;
        const float s1 = wave_sum(lq1[lane] * lk1[lane]), s2 = wave_sum(lq2[lane] * lk2[lane]);
        P.lam = __expf(s1) - __expf(s2) + 0.2f;
        const float mq = wave_max(fabsf(g_dq[lane])), mk = wave_max(fabsf(g_dk[lane]));
        const float bound = 2.0f * (8.0f * mq * mk * 1.02f) + 25.0f;
#pragma unroll
        for (int h = 0; h < 4; ++h) { const float d = ceilf(bound * (float)(4 << (2 * h))); P.Dh[h] = __builtin_amdgcn_readfirstlane(d > 16384.f ? 16384 : (int)d); }
        LAS int* qslot = (LAS int*)(lds + 131072 + 64);
        for (;;) {
            if (tid == 0) *qslot = (int)atomicAdd(ctl, 1u);
            __syncthreads();
            const int it = __builtin_amdgcn_readfirstlane(*qslot);
            __syncthreads();
            if (it >= N_DIFF_ITEMS + N_DIL_ITEMS) break;
            if (it < 256) att::diff_item(it, lds, P);
            else if (it < 256 + N_DIL_ITEMS) att::dil_block(it - 256, lds, P);
            else att::diff_item(it - N_DIL_ITEMS, lds, P);
        }
    }
    xcd_barrier(bar);

    {
        pg8::Gemm g{Y, WOUT, M, DM, DM}; pg8::StaticOrder So; So.init(M, DM, G, (int)blockIdx.x);
        pg8::EpiRes E{x, X1B, SSQ};
        pg8::gemm_phase<pg8::EpiRes, pg8::StaticOrder, true, true>(lds, g, So, E);
    }
    xcd_barrier(bar);

    {
        pg8::Gemm g{X1B, WPG, M, DM, DM}; pg8::StaticOrder So; So.init(M, DM, G, (int)blockIdx.x);
        pg8::EpiGate E{out, X1B, PP, SSQ};
        pg8::gemm_phase<pg8::EpiGate, pg8::StaticOrder, true, true>(lds, g, So, E);
    }
}

extern "C" void kernel_launch(void* const* d_in, const int* in_sizes, int n_in, void* d_out, int out_size, void* d_ws, size_t ws_size, hipStream_t stream) {
    static int grid = 0;
    if (grid == 0) {
        if (n_in != 17 || out_size != M * DM || ws_size < WS_END) { fprintf(stderr, "kernel_launch: unexpected problem shape (n_in %d, out %d, ws %zu)\n", n_in, out_size, ws_size); grid = -1; return; }
        int dev = 0, cus = 0, per_cu = 0;
        hipGetDevice(&dev); hipDeviceGetAttribute(&cus, hipDeviceAttributeMultiprocessorCount, dev);
        if (hipFuncSetAttribute((const void*)hymba_fwd, hipFuncAttributeMaxDynamicSharedMemorySize, LDS_BYTES) != hipSuccess) { fprintf(stderr, "kernel_launch: hipFuncSetAttribute failed\n"); grid = -1; return; }
        if (hipOccupancyMaxActiveBlocksPerMultiprocessor(&per_cu, (const void*)hymba_fwd, NWAVES * 64, LDS_BYTES) != hipSuccess || per_cu < 1) { fprintf(stderr, "kernel_launch: occupancy query gave %d\n", per_cu); per_cu = 1; }
        (void)hipGetLastError();
        grid = cus * per_cu;
    }
    if (grid < 0) return;
    (void)hipMemsetAsync((char*)d_ws + WS_CTL, 0, CTL_ZERO_BYTES, stream);
    Args a{};
    for (int i = 0; i < 17; ++i) a.in[i] = (const float*)d_in[i];
    a.out = (float*)d_out; a.ws = (unsigned char*)d_ws;
    void* kargs[] = {&a};
    const hipError_t e = hipLaunchCooperativeKernel((const void*)hymba_fwd, dim3(grid), dim3(NWAVES * 64), kargs, LDS_BYTES, stream);
    if (e != hipSuccess) fprintf(stderr, "kernel_launch: cooperative launch failed: %s (grid %d)\n", hipGetErrorString(e), grid);
}
```
